# Optimizing an MI355X kernel written in HIP

```python
import jax, jax.numpy as jnp
from jax import lax
import numpy as np

D_MODEL = 4096
BATCH = 4
SEQ = 4096
DEPTH = 1
DEC_BATCH = 32
DEC_SEQ = 16
PAST_LEN = 4096

CHUNK = 64
MIX_WIDTH = D_MODEL
WIDTH_A = MIX_WIDTH // 2
WIDTH_B = MIX_WIDTH - WIDTH_A
GMLP_CHUNK = 128
HEADS_A = 8
HEAD_DIM_A = WIDTH_A // HEADS_A
HGRN_EXPAND = 128
HEADS_B = WIDTH_B // HGRN_EXPAND
DK_B = HGRN_EXPAND
DV_B = WIDTH_B // HEADS_B
D_FF = 4 * D_MODEL
N_IN = 2 * WIDTH_A + 4 * WIDTH_B
SPLITS = [WIDTH_A, 2 * WIDTH_A, 2 * WIDTH_A + WIDTH_B, 2 * WIDTH_A + 2 * WIDTH_B, 2 * WIDTH_A + 3 * WIDTH_B]
EPS = 1e-6

kernel_name = 'hybrid_gmlp_hgrn2_streaming_step'


def rmsnorm(x, g):
    x32 = x.astype(jnp.float32)
    y = x32 * lax.rsqrt(jnp.mean(x32 * x32, axis=-1, keepdims=True) + EPS)
    return (y * g.astype(jnp.float32)).astype(x.dtype)


def chunk_causal_mask(n):
    blk = np.arange(n) // CHUNK
    return jnp.asarray(blk[None, :] <= blk[:, None])


def gmlp_spatial(u, v, w_s, b_s):
    B, T, H, Dh = v.shape
    L = min(T, GMLP_CHUNK)
    n = T // L
    w = jnp.where(chunk_causal_mask(L)[None], w_s[:, :L, :L], 0.0).astype(v.dtype)
    vc = v.reshape(B, n, L, H, Dh)
    mixed = jnp.einsum('hij,bnjhd->bnihd', w, vc) + b_s[:, :L].T.astype(v.dtype)[None, None, :, :, None]
    return u * mixed.reshape(B, T, H, Dh)


def hgrn2_chunkwise(q, k, v, log_f, s0):
    f32 = jnp.float32
    B, T, H, DK = q.shape
    DV = v.shape[-1]
    L = min(T, CHUNK)
    n = T // L
    qc = q.astype(f32).reshape(B, n, L, H, DK)
    kc = k.astype(f32).reshape(B, n, L, H, DK)
    vc = v.astype(f32).reshape(B, n, L, H, DV)
    b = jnp.cumsum(log_f.astype(f32).reshape(B, n, L, H, DK), axis=2)
    b_ref = b[:, :, L // 2:L // 2 + 1]
    b_end = b[:, :, -1]
    q_rel = qc * jnp.exp(b - b_ref)
    k_rel = kc * jnp.exp(b_ref - b)
    scores = jnp.einsum('bnthd,bnshd->bnhts', q_rel, k_rel)
    scores = jnp.where(jnp.tril(jnp.ones((L, L), bool)), scores, 0.0)
    o_intra = jnp.einsum('bnhts,bnshv->bnthv', scores, vc)
    k_end = kc * jnp.exp(b_end[:, :, None] - b)
    ds = jnp.einsum('bnshd,bnshv->bnhdv', k_end, vc)
    decay = jnp.exp(b_end)

    def step(s, inp):
        dec, d = inp
        return dec[..., None] * s + d, s

    s_final, s_start = lax.scan(step, s0.astype(f32), (jnp.moveaxis(decay, 1, 0), jnp.moveaxis(ds, 1, 0)))
    s_start = jnp.moveaxis(s_start, 0, 1)
    o_inter = jnp.einsum('bnthd,bnhdv->bnthv', qc * jnp.exp(b), s_start)
    return (o_intra + o_inter).reshape(B, T, H, DV), s_final


def trunk_layer(x, s0, lb, norm1, w_in, w_s, b_s, norm_v, norm_o, w_out, norm2, w_up, w_down):
    B, T, _ = x.shape
    h = rmsnorm(x, norm1)
    proj = h @ w_in.astype(h.dtype)
    u, v, q, fz, i, g = jnp.split(proj, SPLITS, axis=-1)
    u = jax.nn.gelu(u).reshape(B, T, HEADS_A, HEAD_DIM_A)
    v = rmsnorm(jax.nn.gelu(v).reshape(B, T, HEADS_A, HEAD_DIM_A), norm_v)
    y_a = gmlp_spatial(u, v, w_s, b_s).reshape(B, T, WIDTH_A)
    f = lb + (1.0 - lb) * jax.nn.sigmoid(fz.astype(jnp.float32))
    k = 1.0 - f
    log_f = jnp.log(f)
    qh = jax.nn.silu(q).reshape(B, T, HEADS_B, DK_B)
    o, s_new = hgrn2_chunkwise(qh, k.reshape(B, T, HEADS_B, DK_B), i.reshape(B, T, HEADS_B, DV_B),
                               log_f.reshape(B, T, HEADS_B, DK_B), s0)
    o = rmsnorm(o, norm_o) * jax.nn.silu(g.reshape(B, T, HEADS_B, DV_B)).astype(jnp.float32)
    y_b = o.reshape(B, T, WIDTH_B).astype(x.dtype)
    x = x + jnp.concatenate([y_a, y_b], axis=-1) @ w_out.astype(x.dtype)
    hid = jnp.square(jax.nn.relu(rmsnorm(x, norm2) @ w_up.astype(x.dtype)))
    x = x + hid @ w_down.astype(x.dtype)
    return x, s_new, v.reshape(B, T, WIDTH_A)


def setup_inputs(seed: int = 0) -> dict:
    key = jax.random.key(seed)
    ks = jax.random.split(key, 16)
    f32 = jnp.float32

    def nrm(k, shape, scale):
        return jax.random.normal(k, shape, f32) * scale

    return {
        'x_prompt': nrm(ks[0], (BATCH, SEQ, D_MODEL), 1.0),
        'x_sample': nrm(ks[1], (DEC_BATCH, DEC_SEQ, D_MODEL), 1.0),
        'state_hgrn': nrm(ks[2], (DEPTH, DEC_BATCH, HEADS_B, DK_B, DV_B), 0.5),
        'norm1': 1.0 + nrm(ks[3], (DEPTH, D_MODEL), 0.05),
        'w_in': nrm(ks[4], (DEPTH, D_MODEL, N_IN), D_MODEL ** -0.5),
        'w_s': nrm(ks[5], (DEPTH, HEADS_A, GMLP_CHUNK, GMLP_CHUNK), GMLP_CHUNK ** -0.5),
        'b_s': 1.0 + nrm(ks[6], (DEPTH, HEADS_A, GMLP_CHUNK), 0.1),
        'norm_v': 1.0 + nrm(ks[7], (DEPTH, HEADS_A, HEAD_DIM_A), 0.05),
        'lb_logits': nrm(ks[8], (DEPTH + 1, WIDTH_B), 0.1),
        'norm_o': 1.0 + nrm(ks[9], (DEPTH, HEADS_B, DV_B), 0.05),
        'w_out': nrm(ks[10], (DEPTH, MIX_WIDTH, D_MODEL), MIX_WIDTH ** -0.5),
        'norm2': 1.0 + nrm(ks[11], (DEPTH, D_MODEL), 0.05),
        'w_up': nrm(ks[12], (DEPTH, D_MODEL, D_FF), D_MODEL ** -0.5),
        'w_down': nrm(ks[13], (DEPTH, D_FF, D_MODEL), D_FF ** -0.5),
        'norm_f': 1.0 + nrm(ks[14], (D_MODEL,), 0.05),
    }


def reference(x_prompt, x_sample, state_hgrn, norm1, w_in, w_s, b_s, norm_v, lb_logits, norm_o,
              w_out, norm2, w_up, w_down, norm_f):
    lower_bounds = jnp.cumsum(jax.nn.softmax(lb_logits.astype(jnp.float32), axis=0), axis=0)
    s0_prompt = jnp.zeros((x_prompt.shape[0], HEADS_B, DK_B, DV_B), jnp.float32)
    xp, xs = x_prompt, x_sample
    s_prompt, s_sample, v_sample = [], [], []
    for l in range(DEPTH):
        params = (norm1[l], w_in[l], w_s[l], b_s[l], norm_v[l], norm_o[l], w_out[l], norm2[l], w_up[l], w_down[l])
        xp, sp, _ = trunk_layer(xp, s0_prompt, lower_bounds[l], *params)
        xs, ss, vs = trunk_layer(xs, state_hgrn[l], lower_bounds[l], *params)
        s_prompt.append(sp)
        s_sample.append(ss)
        v_sample.append(vs)
    y_prompt = rmsnorm(xp, norm_f)
    y_sample = rmsnorm(xs, norm_f)
    return (y_prompt, y_sample, jnp.stack(s_prompt), jnp.stack(s_sample), jnp.stack(v_sample))
```

```cpp
#include <hip/hip_runtime.h>
#include <cstdio>
#include <cstdint>
constexpr int DM = 4096, MP = 16384, MS = 512, MT = MP + MS, WA = 2048, NIN = 12288, DFF = 16384;
constexpr float RMS_EPS = 1e-6f;

__device__ __forceinline__ float sigm_f(float z) { return __builtin_amdgcn_rcpf(1.0f + __builtin_amdgcn_exp2f(-1.44269504089f * z)); }
__device__ __forceinline__ float gelu_tanh_f(float x) { const float u = x * __builtin_fmaf(x * x, -0.10294324f, -2.30220820f); return x * __builtin_amdgcn_rcpf(1.0f + __builtin_amdgcn_exp2f(u)); }
__device__ __forceinline__ float silu_f(float x) { return x * sigm_f(x); }
typedef _Float16 h16x2 __attribute__((ext_vector_type(2)));
__device__ __forceinline__ unsigned pk_f16(float lo, float hi) { h16x2 h; h.x = (_Float16)lo; h.y = (_Float16)hi; return __builtin_bit_cast(unsigned, h); }

namespace pg8 {
#define PG8_LAS __attribute__((address_space(3)))
typedef unsigned short bf16_t;
typedef short bf16x8 __attribute__((ext_vector_type(8)));
typedef float f32x4 __attribute__((ext_vector_type(4)));
typedef unsigned u32x4 __attribute__((ext_vector_type(4)));
constexpr int BM = 256, BK = 64, HALF = 128, HTB = HALF * BK * 2  , STAGE_BYTES = 8 * HTB, NXCD = 8, WGM = 8;

__host__ __device__ __forceinline__ int lds_byte(int r, int c) { const int st = (r >> 4) * 2 + (c >> 5), rr = r & 15, cc = c & 31, ob = rr * 64 + cc * 2; return st * 1024 + (ob ^ (((ob >> 9) & 1) << 5)); }
__host__ __device__ __forceinline__ void stage_rc(int b, int& R, int& C) { const int st = b / 1024, sb = b % 1024, swz = sb ^ (((sb >> 9) & 1) << 5); R = (st >> 1) * 16 + swz / 64; C = (st & 1) * 32 + (swz % 64) / 2; }
__host__ __device__ __forceinline__ int perm32(int rho) { const int n = rho >> 4, i = rho & 15; return 8 * (i >> 2) + 4 * n + (i & 3); }

struct Unit { int pm, pn, k0; };
struct Gemm { const bf16_t* A; const bf16_t* Bt; int M, N, K, lda; };

struct StaticOrder {
    int nM, nN, nwg, G, c, wgm;
    __host__ __device__ void init(int M, int N, int G_, int c_, int wgm_ = WGM) { nM = M / BM; nN = N / BM; nwg = nM * nN; G = G_; c = c_; wgm = wgm_; }
    __host__ __device__ bool next(int i, Unit& u) const {
        const long L = (long)i * G + c; if (L >= nwg) return false;
        int wgid = (int)L; { const int q = nwg / NXCD, r = nwg % NXCD, xcd = wgid % NXCD, off = wgid / NXCD; wgid = (xcd < r ? xcd * (q + 1) : r * (q + 1) + (xcd - r) * q) + off; }
        const int nig = wgm * nN, gid = wgid / nig, fm = gid * wgm, gsz = (nM - fm) < wgm ? (nM - fm) : wgm;
        u.pm = fm + ((wgid % nig) % gsz); u.pn = (wgid % nig) / gsz; u.k0 = 0; return true;
    }
    __device__ __forceinline__ void a_ready(const Unit&) const {}
    __device__ __forceinline__ void done(const Unit&) const {}
};
__device__ __forceinline__ unsigned cvt_pk_bf16(float lo, float hi) { unsigned r; asm volatile("v_cvt_pk_bf16_f32 %0, %1, %2" : "=v"(r) : "v"(lo), "v"(hi)); return r; }
typedef float f32x2 __attribute__((ext_vector_type(2)));
struct EpiProj {
    static constexpr bool PERM = true, AFTER_DRAIN = false;
    bf16_t* P; const float* lbl;
    template <int ACT> __device__ __forceinline__ void run(const f32x4 (&acc)[2][2][4][2], bf16_t* base, int row0, int col0) const {
        f32x4 lb[2][2];
#pragma unroll
        for (int bj = 0; bj < 2; ++bj)
#pragma unroll
            for (int n = 0; n < 2; ++n) {
                if (ACT == 2) { const f32x4 a = *(const f32x4*)(lbl + col0 + bj * HALF + 4 * n), b = *(const f32x4*)(lbl + 2048 + col0 + bj * HALF + 4 * n);
#pragma unroll
                    for (int e = 0; e < 4; ++e) lb[bj][n][e] = sigm_f(a[e] - b[e]); }
                else lb[bj][n] = (f32x4){0.f, 0.f, 0.f, 0.f}; }
#pragma unroll
        for (int ai = 0; ai < 2; ++ai)
#pragma unroll
            for (int m = 0; m < 4; ++m) { bf16_t* rowp = base + (size_t)(row0 + ai * HALF + m * 16) * 2048 + col0;
#pragma unroll
                for (int bj = 0; bj < 2; ++bj) { f32x4 v0 = acc[ai][bj][m][0], v1 = acc[ai][bj][m][1]; u32x4 w;
#pragma unroll
                    for (int e = 0; e < 4; ++e) {
                        if (ACT == 0) { v0[e] = gelu_tanh_f(v0[e]); v1[e] = gelu_tanh_f(v1[e]); }
                        if (ACT == 1) { v0[e] = silu_f(v0[e]); v1[e] = silu_f(v1[e]); }
                        if (ACT == 2) { const float l0 = lb[bj][0][e], l1 = lb[bj][1][e];
                            v0[e] = l0 + (1.0f - l0) * sigm_f(v0[e]); v1[e] = l1 + (1.0f - l1) * sigm_f(v1[e]); } }
                    if (ACT == 2) { w.x = pk_f16(v0[0], v0[1]); w.y = pk_f16(v0[2], v0[3]); w.z = pk_f16(v1[0], v1[1]); w.w = pk_f16(v1[2], v1[3]); }
                    else { w.x = cvt_pk_bf16(v0[0], v0[1]); w.y = cvt_pk_bf16(v0[2], v0[3]); w.z = cvt_pk_bf16(v1[0], v1[1]); w.w = cvt_pk_bf16(v1[2], v1[3]); }
                    *(u32x4*)(rowp + bj * HALF) = w; } }
    }
    __device__ __forceinline__ void operator()(const f32x4 (&acc)[2][2][4][2], const Unit& u, int wr, int wc, int fr, int fq) const {
        const int region = u.pn >> 3, row0 = u.pm * BM + wr * 64 + fr, col0 = (u.pn & 7) * BM + wc * 32 + 8 * fq;
        bf16_t* base = P + (size_t)region * ((size_t)MT * 2048);
        if (region <= 1) run<0>(acc, base, row0, col0);
        else if (region == 2 || region == 5) run<1>(acc, base, row0, col0);
        else if (region == 3) run<2>(acc, base, row0, col0);
        else run<3>(acc, base, row0, col0);
    }
};
__device__ __forceinline__ void epi_load_batch(const float* base, size_t off0, f32x4 (&b)[2][4]) {
#pragma unroll
    for (int r = 0; r < 2; ++r)
#pragma unroll
        for (int bj = 0; bj < 2; ++bj)
#pragma unroll
            for (int n = 0; n < 2; ++n) b[r][bj * 2 + n] = __builtin_nontemporal_load((const f32x4*)(base + off0 + (size_t)r * 16 * DM + bj * HALF + n * 16));
}
struct EpiRes {
    static constexpr bool PERM = false, AFTER_DRAIN = false;
    const float* bp; const float* bs; float* out;
    __device__ __forceinline__ void store_batch(const f32x4 (&acc)[2][2][4][2], int batch, size_t off0, const f32x4 (&b)[2][4]) const {
        const int ai = batch >> 1, m0 = (batch & 1) * 2;
#pragma unroll
        for (int r = 0; r < 2; ++r)
#pragma unroll
            for (int bj = 0; bj < 2; ++bj)
#pragma unroll
                for (int n = 0; n < 2; ++n) *(f32x4*)(out + off0 + (size_t)r * 16 * DM + bj * HALF + n * 16) = acc[ai][bj][m0 + r][n] + b[r][bj * 2 + n];
    }
    __device__ __forceinline__ void operator()(const f32x4 (&acc)[2][2][4][2], const Unit& u, int wr, int wc, int fr, int fq) const {
        const int row0 = u.pm * BM + wr * 64 + fr, col0 = u.pn * BM + wc * 32 + 4 * fq;
        const float* base = (u.pm < MP / BM) ? bp : bs - (size_t)MP * DM;
        size_t off[4];
#pragma unroll
        for (int t = 0; t < 4; ++t) off[t] = (size_t)(row0 + (t >> 1) * HALF + (t & 1) * 32) * DM + col0;
        f32x4 b0[2][4], b1[2][4];
        epi_load_batch(base, off[0], b0); epi_load_batch(base, off[1], b1);
        asm volatile("" ::: "memory");
        store_batch(acc, 0, off[0], b0); epi_load_batch(base, off[2], b0);
        asm volatile("" ::: "memory");
        store_batch(acc, 1, off[1], b1); epi_load_batch(base, off[3], b1);
        asm volatile("" ::: "memory");
        store_batch(acc, 2, off[2], b0);
        store_batch(acc, 3, off[3], b1);
    }
};
struct EpiResNorm {
    static constexpr bool PERM = false, AFTER_DRAIN = false;
    const float* bp; float* out; bf16_t* xg; const float* g; float* ssq; bool store_x1;
    __device__ __forceinline__ void store_batch(const f32x4 (&acc)[2][2][4][2], int batch, size_t off0, int rowb, const f32x4 (&b)[2][4], const f32x4 (&gv)[2][2], int fq) const {
        typedef unsigned u32x2 __attribute__((ext_vector_type(2)));
        const int ai = batch >> 1, m0 = (batch & 1) * 2;
#pragma unroll
        for (int r = 0; r < 2; ++r) { float sq = 0.f;
#pragma unroll
            for (int bj = 0; bj < 2; ++bj)
#pragma unroll
                for (int n = 0; n < 2; ++n) { const f32x4 x = acc[ai][bj][m0 + r][n] + b[r][bj * 2 + n]; const size_t o = off0 + (size_t)r * 16 * DM + bj * HALF + n * 16; if (store_x1) *(f32x4*)(out + o) = x;
                    sq += (x[0] * x[0] + x[1] * x[1]) + (x[2] * x[2] + x[3] * x[3]); const f32x4 y = x * gv[bj][n];
                    u32x2 w; w.x = cvt_pk_bf16(y[0], y[1]); w.y = cvt_pk_bf16(y[2], y[3]); *(u32x2*)(xg + o) = w; }
            sq += __shfl_xor(sq, 16); sq += __shfl_xor(sq, 32);
            if (fq == 0) atomicAdd(ssq + rowb + r * 16, sq); }
    }
    __device__ __forceinline__ void operator()(const f32x4 (&acc)[2][2][4][2], const Unit& u, int wr, int wc, int fr, int fq) const {
        const int row0 = u.pm * BM + wr * 64 + fr, col0 = u.pn * BM + wc * 32 + 4 * fq;
        f32x4 gv[2][2];
#pragma unroll
        for (int bj = 0; bj < 2; ++bj)
#pragma unroll
            for (int n = 0; n < 2; ++n) gv[bj][n] = *(const f32x4*)(g + col0 + bj * HALF + n * 16);
        size_t off[4]; int rowb[4];
#pragma unroll
        for (int t = 0; t < 4; ++t) { rowb[t] = row0 + (t >> 1) * HALF + (t & 1) * 32; off[t] = (size_t)rowb[t] * DM + col0; }
        f32x4 b0[2][4], b1[2][4];
        epi_load_batch(bp, off[0], b0); epi_load_batch(bp, off[1], b1);
        asm volatile("" ::: "memory");
        store_batch(acc, 0, off[0], rowb[0], b0, gv, fq); epi_load_batch(bp, off[2], b0);
        asm volatile("" ::: "memory");
        store_batch(acc, 1, off[1], rowb[1], b1, gv, fq); epi_load_batch(bp, off[3], b1);
        asm volatile("" ::: "memory");
        store_batch(acc, 2, off[2], rowb[2], b0, gv, fq);
        store_batch(acc, 3, off[3], rowb[3], b1, gv, fq);
    }
};
struct PairOrder {
    StaticOrder so; bool paired;
    __host__ __device__ void init(int M, int N, int G_, int c_) { so.init(M, N, G_, c_, 4); paired = (G_ == 256 && M / BM == 64 && N / BM == 16); }
    __host__ __device__ bool next(int i, Unit& u) const {
        if (!paired) return so.next(i, u);
        if (i >= 4) return false;
        const int xcd = so.c & 7, j = so.c >> 3;
        u.pm = 4 * ((xcd >> 1) + 4 * i) + (j & 3); u.pn = 8 * (xcd & 1) + (j >> 2); u.k0 = 0; return true;
    }
    __device__ __forceinline__ void a_ready(const Unit&) const {}
    __device__ __forceinline__ void done(const Unit&) const {}
};
struct EpiResFinal {
    static constexpr bool PERM = false, AFTER_DRAIN = false;
    float* out; const float* g; float* ssq2; unsigned* cnt; const bf16_t* xg; const float* g2;
    __device__ __forceinline__ void add_batch(f32x4 (&acc)[2][2][4][2], int batch, int rowb, const f32x4 (&b)[2][4], int fq) const {
        const int ai = batch >> 1, m0 = (batch & 1) * 2;
#pragma unroll
        for (int r = 0; r < 2; ++r) { float sq = 0.f;
#pragma unroll
            for (int bj = 0; bj < 2; ++bj)
#pragma unroll
                for (int n = 0; n < 2; ++n) { const f32x4 x = acc[ai][bj][m0 + r][n] + b[r][bj * 2 + n]; acc[ai][bj][m0 + r][n] = x; sq += (x[0] * x[0] + x[1] * x[1]) + (x[2] * x[2] + x[3] * x[3]); }
            sq += __shfl_xor(sq, 16); sq += __shfl_xor(sq, 32);
            if (fq == 0) atomicAdd(ssq2 + rowb + r * 16, sq); }
    }
    __device__ __forceinline__ void load_x1(size_t off0, f32x4 (&b)[2][4], const f32x4 (&ig)[2][2]) const {
        typedef unsigned u32x2 __attribute__((ext_vector_type(2)));
#pragma unroll
        for (int r = 0; r < 2; ++r)
#pragma unroll
            for (int bj = 0; bj < 2; ++bj)
#pragma unroll
                for (int n = 0; n < 2; ++n) { const u32x2 w = __builtin_nontemporal_load((const u32x2*)(xg + off0 + (size_t)r * 16 * DM + bj * HALF + n * 16));
                    b[r][bj * 2 + n] = (f32x4){__builtin_bit_cast(float, w.x << 16), __builtin_bit_cast(float, w.x & 0xffff0000u), __builtin_bit_cast(float, w.y << 16), __builtin_bit_cast(float, w.y & 0xffff0000u)} * ig[bj][n]; }
    }
    __device__ __forceinline__ void operator()(const f32x4 (&acc_c)[2][2][4][2], const Unit& u, int wr, int wc, int fr, int fq) const {
        f32x4 (&acc)[2][2][4][2] = const_cast<f32x4 (&)[2][2][4][2]>(acc_c);
        const int row0 = u.pm * BM + wr * 64 + fr, col0 = u.pn * BM + wc * 32 + 4 * fq;
        size_t off[4]; int rowb[4];
#pragma unroll
        for (int t = 0; t < 4; ++t) { rowb[t] = row0 + (t >> 1) * HALF + (t & 1) * 32; off[t] = (size_t)rowb[t] * DM + col0; }
        f32x4 ig[2][2];
#pragma unroll
        for (int bj = 0; bj < 2; ++bj)
#pragma unroll
            for (int n = 0; n < 2; ++n) { const f32x4 gg = *(const f32x4*)(g2 + col0 + bj * HALF + n * 16); ig[bj][n] = (f32x4){__builtin_amdgcn_rcpf(gg[0]), __builtin_amdgcn_rcpf(gg[1]), __builtin_amdgcn_rcpf(gg[2]), __builtin_amdgcn_rcpf(gg[3])}; }
        f32x4 b0[2][4], b1[2][4];
        load_x1(off[0], b0, ig); load_x1(off[1], b1, ig);
        asm volatile("" ::: "memory");
        add_batch(acc, 0, rowb[0], b0, fq); load_x1(off[2], b0, ig);
        asm volatile("" ::: "memory");
        add_batch(acc, 1, rowb[1], b1, fq); load_x1(off[3], b1, ig);
        asm volatile("" ::: "memory");
        add_batch(acc, 2, rowb[2], b0, fq);
        add_batch(acc, 3, rowb[3], b1, fq);
        asm volatile("s_waitcnt vmcnt(0)" ::: "memory");
        unsigned* pc = cnt + 64 * u.pm;
        if (fr == 0 && fq == 0) __hip_atomic_fetch_add(pc, 1u, __ATOMIC_RELAXED, __HIP_MEMORY_SCOPE_AGENT);
        for (unsigned spins = 0; (unsigned)__builtin_amdgcn_readfirstlane((int)__hip_atomic_load(pc, __ATOMIC_RELAXED, __HIP_MEMORY_SCOPE_AGENT)) < 128u; ) { __builtin_amdgcn_s_sleep(2); if (++spins > (1u << 17)) break; }
        f32x4 gv[2][2];
#pragma unroll
        for (int bj = 0; bj < 2; ++bj)
#pragma unroll
            for (int n = 0; n < 2; ++n) gv[bj][n] = *(const f32x4*)(g + col0 + bj * HALF + n * 16);
        unsigned sqb[4][2];
#pragma unroll
        for (int t = 0; t < 4; ++t)
#pragma unroll
            for (int r = 0; r < 2; ++r) sqb[t][r] = __hip_atomic_load((unsigned*)(ssq2 + rowb[t] + r * 16), __ATOMIC_RELAXED, __HIP_MEMORY_SCOPE_AGENT);
        asm volatile("" ::: "memory");
#pragma unroll
        for (int t = 0; t < 4; ++t) { const int ai = t >> 1, m0 = (t & 1) * 2;
#pragma unroll
            for (int r = 0; r < 2; ++r) { const float sq = __builtin_bit_cast(float, sqb[t][r]);
                const float rs = __builtin_amdgcn_rsqf(sq * (1.f / DM) + RMS_EPS);
#pragma unroll
                for (int bj = 0; bj < 2; ++bj)
#pragma unroll
                    for (int n = 0; n < 2; ++n) __builtin_nontemporal_store(acc[ai][bj][m0 + r][n] * gv[bj][n] * rs, (f32x4*)(out + off[t] + (size_t)r * 16 * DM + bj * HALF + n * 16)); } }
    }
};
struct SplitOrder {
    int nN, nsplit, kext, pm0, ntot, G, c;
    __host__ __device__ void init(int pm0_, int nMs, int N, int nsplit_, int kext_, int G_, int c_) { nN = N / BM; nsplit = nsplit_; kext = kext_; pm0 = pm0_; ntot = nMs * nN * nsplit; G = G_; c = c_; }
    __host__ __device__ bool next(int i, Unit& u) const { const int j = i * G + c; if (j >= ntot) return false; const int ks = j % nsplit, r = j / nsplit; u.pn = r % nN; u.pm = pm0 + r / nN; u.k0 = ks * kext; return true; }
    __device__ __forceinline__ void a_ready(const Unit&) const {}
    __device__ __forceinline__ void done(const Unit&) const {}
};
struct EpiPart {
    static constexpr bool PERM = false, AFTER_DRAIN = false;
    float* part; int kext;
    __device__ __forceinline__ void operator()(const f32x4 (&acc)[2][2][4][2], const Unit& u, int wr, int wc, int fr, int fq) const {
        const int row0 = u.pm * BM - MP + wr * 64 + fr, col0 = u.pn * BM + wc * 32 + 4 * fq;
        float* base = part + (size_t)(u.k0 / kext) * ((size_t)MS * DM);
#pragma unroll
        for (int ai = 0; ai < 2; ++ai)
#pragma unroll
            for (int m = 0; m < 4; ++m) { const size_t off = (size_t)(row0 + ai * HALF + m * 16) * DM + col0;
#pragma unroll
                for (int bj = 0; bj < 2; ++bj)
#pragma unroll
                    for (int n = 0; n < 2; ++n) *(f32x4*)(base + off + bj * HALF + n * 16) = acc[ai][bj][m][n]; }
    }
};
struct EpiRelu2 {
    static constexpr bool PERM = true, AFTER_DRAIN = false;
    bf16_t* O; int ldc; const float* ssq;
    __device__ __forceinline__ void operator()(const f32x4 (&acc)[2][2][4][2], const Unit& u, int wr, int wc, int fr, int fq) const {
        const int row0 = u.pm * BM + wr * 64 + fr, col0 = u.pn * BM + wc * 32 + 8 * fq;
        float r2[2][4];
#pragma unroll
        for (int ai = 0; ai < 2; ++ai)
#pragma unroll
            for (int m = 0; m < 4; ++m) r2[ai][m] = __builtin_amdgcn_rcpf(ssq[row0 + ai * HALF + m * 16] * (1.f / DM) + RMS_EPS);
#pragma unroll
        for (int ai = 0; ai < 2; ++ai)
#pragma unroll
            for (int m = 0; m < 4; ++m) { bf16_t* rowp = O + (size_t)(row0 + ai * HALF + m * 16) * ldc + col0;
#pragma unroll
                for (int bj = 0; bj < 2; ++bj) { f32x4 v0 = acc[ai][bj][m][0], v1 = acc[ai][bj][m][1];
#pragma unroll
                    for (int e = 0; e < 4; ++e) { const float a = fmaxf(v0[e], 0.f), b = fmaxf(v1[e], 0.f); v0[e] = a * a * r2[ai][m]; v1[e] = b * b * r2[ai][m]; }
                    u32x4 w; w.x = cvt_pk_bf16(v0[0], v0[1]); w.y = cvt_pk_bf16(v0[2], v0[3]); w.z = cvt_pk_bf16(v1[0], v1[1]); w.w = cvt_pk_bf16(v1[2], v1[3]);
                    *(u32x4*)(rowp + bj * HALF) = w; } }
    }
};
template <class Epi, class Sched, bool ALIGN_EPI = false, bool SP2 = false>
__device__ __forceinline__ void gemm_phase(PG8_LAS unsigned char* lds, const Gemm g, const Sched& S, const Epi& E) {
    const int tid = threadIdx.x, wid = __builtin_amdgcn_readfirstlane(tid >> 6), lane = tid & 63, wr = wid >> 2, wc = wid & 3, fr = lane & 15, fq = lane >> 4;
    const int K = g.lda, nt = g.K / BK;
    unsigned voffA[2], voffB[2];
#pragma unroll
    for (int i = 0; i < 2; ++i) { int R, C; stage_rc(tid * 16 + i * 8192, R, C); const int Rb = Epi::PERM ? ((R & ~31) + perm32(R & 31)) : R;
        voffA[i] = (unsigned)(R * K + C) * 2u; voffB[i] = (unsigned)(Rb * K + C) * 2u; }
    const size_t kstep = (size_t)(BK * 2);
    const size_t hstep = (size_t)HALF * K * 2;
    const size_t tstep = 2 * hstep;
    const unsigned ldsw = (unsigned)wid * 1024u;
    const int aoff = lds_byte(wr * 64 + fr, fq * 8), boff = lds_byte(wc * 32 + fr, fq * 8);
#define PG8_SA(b, h) (((b) * 2 + (h)) * HTB)
#define PG8_SB(b, h) ((4 + (b) * 2 + (h)) * HTB)
#define PG8_STAGE(bufoff, gbase, voff) do { _Pragma("unroll") for (int _i = 0; _i < 2; ++_i) \
        __builtin_amdgcn_global_load_lds((const unsigned*)((const char*)(gbase) + (voff)[_i]), (PG8_LAS unsigned*)(lds + (bufoff) + ldsw + _i * 8192), 16, 0, 0); } while (0)
#define PG8_LDA(dst, b, h) do { _Pragma("unroll") for (int m = 0; m < 4; ++m) _Pragma("unroll") for (int k = 0; k < 2; ++k) dst[m][k] = *(const PG8_LAS bf16x8*)(lds + PG8_SA(b, h) + aoff + m * 2048 + k * 1024); } while (0)
#define PG8_LDB(dst, b, h) do { _Pragma("unroll") for (int n = 0; n < 2; ++n) _Pragma("unroll") for (int k = 0; k < 2; ++k) dst[n][k] = *(const PG8_LAS bf16x8*)(lds + PG8_SB(b, h) + boff + n * 2048 + k * 1024); } while (0)
#define PG8_MMA(ai, bj, At, Bt) do { __builtin_amdgcn_s_setprio(1); _Pragma("unroll") for (int m = 0; m < 4; ++m) _Pragma("unroll") for (int n = 0; n < 2; ++n) _Pragma("unroll") for (int k = 0; k < 2; ++k) \
        acc[ai][bj][m][n] = __builtin_amdgcn_mfma_f32_16x16x32_bf16(Bt[n][k], At[m][k], acc[ai][bj][m][n], 0, 0, 0); __builtin_amdgcn_s_setprio(0); } while (0)
#define PG8_WAIT_V(n) asm volatile("s_waitcnt vmcnt(" #n ")" ::: "memory")
#define PG8_WAIT_L(n) asm volatile("s_waitcnt lgkmcnt(" #n ")" ::: "memory")
#define PG8_BAR __builtin_amdgcn_s_barrier()
#define PG8_SCHED __builtin_amdgcn_sched_barrier(0)
    Unit cur, nxt; int ui = 0;
    if (!S.next(0, cur)) return;
    f32x4 acc[2][2][4][2];
#pragma unroll
    for (int a = 0; a < 2; ++a)
#pragma unroll
        for (int b = 0; b < 2; ++b)
#pragma unroll
            for (int m = 0; m < 4; ++m)
#pragma unroll
                for (int n = 0; n < 2; ++n) acc[a][b][m][n] = (f32x4){0.f, 0.f, 0.f, 0.f};
    bf16x8 At[4][2], B0[2][2], B1[2][2];
    const char* cA = (const char*)g.A + (size_t)cur.pm * tstep + (size_t)cur.k0 * 2; const char* cB = (const char*)g.Bt + (size_t)cur.pn * tstep + (size_t)cur.k0 * 2;
    S.a_ready(cur);
    if constexpr (SP2) {
        PG8_STAGE(PG8_SB(0, 0), cB, voffB); PG8_STAGE(PG8_SB(0, 1), cB + hstep, voffB); PG8_STAGE(PG8_SA(0, 0), cA, voffA); PG8_STAGE(PG8_SA(0, 1), cA + hstep, voffA);
        if (wr == 1) PG8_BAR;
        PG8_WAIT_V(2); PG8_BAR;
        PG8_STAGE(PG8_SB(1, 0), cB + kstep, voffB); PG8_STAGE(PG8_SA(1, 0), cA + kstep, voffA); PG8_STAGE(PG8_SB(1, 1), cB + hstep + kstep, voffB);
        PG8_WAIT_V(6); PG8_BAR;
    } else {
        PG8_STAGE(PG8_SB(0, 0), cB, voffB); PG8_STAGE(PG8_SA(0, 0), cA, voffA); PG8_STAGE(PG8_SB(0, 1), cB + hstep, voffB); PG8_STAGE(PG8_SA(0, 1), cA + hstep, voffA);
        if (wr == 1) PG8_BAR;
        PG8_WAIT_V(4); PG8_BAR;
        PG8_STAGE(PG8_SB(1, 0), cB + kstep, voffB); PG8_STAGE(PG8_SA(1, 0), cA + kstep, voffA); PG8_STAGE(PG8_SB(1, 1), cB + hstep + kstep, voffB);
        PG8_WAIT_V(6); PG8_BAR;
    }
    for (;;) {
        const bool has_next = S.next(ui + 1, nxt);
        const char* nA = has_next ? (const char*)g.A + (size_t)nxt.pm * tstep + (size_t)nxt.k0 * 2 : cA; const char* nB = has_next ? (const char*)g.Bt + (size_t)nxt.pn * tstep + (size_t)nxt.k0 * 2 : cB;
        for (int t = 0; t < nt; t += 2) {
            const bool last = (t == nt - 2);
            const char* a1 = cA + (size_t)(t + 1) * kstep;
            const char* a2 = last ? nA : cA + (size_t)(t + 2) * kstep; const char* b2 = last ? nB : cB + (size_t)(t + 2) * kstep;
            const char* a3 = a2 + kstep; const char* b3 = b2 + kstep;
            if (last && has_next) S.a_ready(nxt);
            if constexpr (SP2) {
            PG8_LDB(B0, 0, 0); PG8_LDB(B1, 0, 1); PG8_SCHED; PG8_LDA(At, 0, 0); PG8_STAGE(PG8_SA(1, 1), a1 + hstep, voffA);
            PG8_WAIT_V(8); PG8_WAIT_L(0); PG8_BAR; PG8_MMA(0, 0, At, B0); PG8_MMA(0, 1, At, B1); PG8_BAR; PG8_SCHED;
            PG8_LDA(At, 0, 1); PG8_STAGE(PG8_SB(0, 0), b2, voffB); PG8_STAGE(PG8_SB(0, 1), b2 + hstep, voffB); PG8_STAGE(PG8_SA(0, 0), a2, voffA);
            PG8_WAIT_V(8); PG8_WAIT_L(0); PG8_BAR; PG8_MMA(1, 0, At, B0); PG8_MMA(1, 1, At, B1); PG8_BAR; PG8_SCHED;
            PG8_LDB(B0, 1, 0); PG8_LDB(B1, 1, 1); PG8_SCHED; PG8_LDA(At, 1, 0); PG8_STAGE(PG8_SA(0, 1), a2 + hstep, voffA);
            PG8_WAIT_V(8); PG8_WAIT_L(0); PG8_BAR; PG8_MMA(0, 0, At, B0); PG8_MMA(0, 1, At, B1); PG8_BAR; PG8_SCHED;
            PG8_LDA(At, 1, 1); PG8_STAGE(PG8_SB(1, 0), b3, voffB); PG8_STAGE(PG8_SB(1, 1), b3 + hstep, voffB); PG8_STAGE(PG8_SA(1, 0), a3, voffA);
            PG8_WAIT_V(8); PG8_WAIT_L(0); PG8_BAR; PG8_MMA(1, 0, At, B0); PG8_MMA(1, 1, At, B1); PG8_BAR; PG8_SCHED;
            } else {
            PG8_LDB(B0, 0, 0); PG8_SCHED; PG8_LDA(At, 0, 0); PG8_STAGE(PG8_SA(1, 1), a1 + hstep, voffA);
            PG8_WAIT_L(8); PG8_BAR; PG8_WAIT_L(0); PG8_MMA(0, 0, At, B0); PG8_BAR; PG8_SCHED;
            PG8_LDB(B1, 0, 1); PG8_STAGE(PG8_SB(0, 0), b2, voffB);
            PG8_BAR; PG8_WAIT_L(0); PG8_MMA(0, 1, At, B1); PG8_BAR;
            PG8_LDA(At, 0, 1); PG8_STAGE(PG8_SA(0, 0), a2, voffA);
            PG8_BAR; PG8_WAIT_L(0); PG8_MMA(1, 0, At, B0); PG8_BAR; PG8_SCHED;
            PG8_STAGE(PG8_SB(0, 1), b2 + hstep, voffB);
            PG8_WAIT_V(6); PG8_BAR; PG8_MMA(1, 1, At, B1); PG8_BAR;
            PG8_LDB(B0, 1, 0); PG8_SCHED; PG8_LDA(At, 1, 0); PG8_STAGE(PG8_SA(0, 1), a2 + hstep, voffA);
            PG8_WAIT_L(8); PG8_BAR; PG8_WAIT_L(0); PG8_MMA(0, 0, At, B0); PG8_BAR; PG8_SCHED;
            PG8_LDB(B1, 1, 1); PG8_STAGE(PG8_SB(1, 0), b3, voffB);
            PG8_BAR; PG8_WAIT_L(0); PG8_MMA(0, 1, At, B1); PG8_BAR;
            PG8_LDA(At, 1, 1); PG8_STAGE(PG8_SA(1, 0), a3, voffA);
            PG8_BAR; PG8_WAIT_L(0); PG8_MMA(1, 0, At, B0); PG8_BAR; PG8_SCHED;
            PG8_STAGE(PG8_SB(1, 1), b3 + hstep, voffB);
            PG8_WAIT_V(6); PG8_BAR; PG8_MMA(1, 1, At, B1); PG8_BAR;
            }
        }
        if constexpr (ALIGN_EPI) { if (wr == 0) PG8_BAR; }
        if constexpr (!Epi::AFTER_DRAIN) { E(acc, cur, wr, wc, fr, fq); S.done(cur); }
        if (!has_next) break;
#pragma unroll
        for (int a = 0; a < 2; ++a)
#pragma unroll
            for (int b = 0; b < 2; ++b)
#pragma unroll
                for (int m = 0; m < 4; ++m)
#pragma unroll
                    for (int n = 0; n < 2; ++n) acc[a][b][m][n] = (f32x4){0.f, 0.f, 0.f, 0.f};
        cur = nxt; cA = nA; cB = nB; ++ui;
        if constexpr (ALIGN_EPI) { if (wr == 1) PG8_BAR; }
    }
    PG8_WAIT_V(0);
    if constexpr (!ALIGN_EPI) { if (wr == 0) PG8_BAR; }
    PG8_BAR;
    if constexpr (Epi::AFTER_DRAIN) { E.fused(acc, cur, wr, wc, fr, fq, lds, wid, lane); S.done(cur); }
#undef PG8_SA
#undef PG8_SB
#undef PG8_STAGE
#undef PG8_LDA
#undef PG8_LDB
#undef PG8_MMA
#undef PG8_WAIT_V
#undef PG8_WAIT_L
#undef PG8_BAR
#undef PG8_SCHED
}
}
#define GAS __attribute__((address_space(1)))
#define LAS __attribute__((address_space(3)))
typedef unsigned short bf16;
typedef float f32x4 __attribute__((ext_vector_type(4)));
typedef float f32x2 __attribute__((ext_vector_type(2)));
typedef unsigned v4u __attribute__((ext_vector_type(4)));
typedef unsigned v2u __attribute__((ext_vector_type(2)));
typedef GAS unsigned gu32;
#define RLX_AGENT __ATOMIC_RELAXED, __HIP_MEMORY_SCOPE_AGENT
#define LDS_WAIT() asm volatile("s_waitcnt lgkmcnt(0)" ::: "memory")
#define VM_WAIT() asm volatile("s_waitcnt vmcnt(0)" ::: "memory")
#define LBAR() do { asm volatile("s_waitcnt lgkmcnt(0)" ::: "memory"); __builtin_amdgcn_s_barrier(); asm volatile("" ::: "memory"); } while (0)
#define SCHED_FENCE() __builtin_amdgcn_sched_barrier(0)
constexpr int NWAVES = 8;
constexpr int NHEAVY = 128, HSPLIT = 39;
#ifndef MK_N_LAUNCHES
#define MK_N_LAUNCHES 1
#endif
constexpr int NPHASES = 9;
constexpr int N_LAUNCHES = MK_N_LAUNCHES;

constexpr size_t MiB = 1u << 20;
constexpr size_t WS_CTL = 0, CTL_ZERO_BYTES = 1 * MiB;
constexpr size_t WS_WUP = 2 * MiB, WS_WDN = 130 * MiB;
constexpr size_t WS_XN2 = 258 * MiB;
constexpr size_t WS_P = 390 * MiB, P_STRIDE = (size_t)MT * 2048 * 2;
constexpr size_t WS_XN = WS_P + 6 * P_STRIDE;
constexpr size_t WS_HID = WS_P;
constexpr size_t WS_WIN = WS_HID + (size_t)MT * DFF * 2, WS_WOUT = WS_WIN + (size_t)NIN * DM * 2;
constexpr size_t WS_END = WS_WOUT + (size_t)DM * DM * 2;
constexpr size_t WS_PART1 = WS_P, WS_PART2 = WS_WUP;
constexpr size_t CTL_SSQ2 = 384 * 1024, CTL_PANEL = 512 * 1024;
constexpr size_t CTL_SSQ = 256 * 1024;
static_assert(WS_WUP + (size_t)DFF * DM * 2 <= WS_WDN && WS_WDN + (size_t)DM * DFF * 2 <= WS_XN2 && WS_XN2 + (size_t)MT * DM * 2 <= WS_P, "ws map: weights / XN2");
static_assert(WS_XN + (size_t)MT * DM * 2 <= WS_WIN && WS_XN + (size_t)MT * DM * 2 == WS_HID + (size_t)MT * DFF * 2 && CTL_SSQ + (size_t)MT * 4 <= CTL_ZERO_BYTES, "ws map: activations");
constexpr int CW_BAR = 4096;
constexpr size_t OUT_Y = 0, OUT_SP = (size_t)MT * DM, OUT_SS = OUT_SP + (size_t)4 * 16 * 128 * 128, OUT_VS = OUT_SS + (size_t)32 * 16 * 128 * 128, OUT_END = OUT_VS + (size_t)32 * 16 * 2048;
constexpr int RING_OFF = 0, RING_BYTES = 131072;
constexpr int LDS_BYTES = 163840;
constexpr int LDSCTL_OFF = LDS_BYTES - 1024, MISC_OFF = LDSCTL_OFF + 320;

__device__ __forceinline__ unsigned f2bf(float f) { unsigned u = __builtin_bit_cast(unsigned, f); return (u + 0x7fffu + ((u >> 16) & 1u)) >> 16; }
__device__ __forceinline__ unsigned pk2(float lo, float hi) { return f2bf(lo) | (f2bf(hi) << 16); }
__device__ __forceinline__ float bf2f(unsigned b) { return __builtin_bit_cast(float, b << 16); }
__device__ __forceinline__ float h2f(unsigned h) { return (float)__builtin_bit_cast(_Float16, (unsigned short)h); }
#define XB_TMO      128
#define XB_XCNT(j)  (256  + 64 * (j))
#define XB_XSUB(j)  (1280 + 64 * (j))
#define XB_XGEN(j)  (2304 + 64 * (j))
#define XB_TOP      3328
#define XB_TOPGEN   3392
#define XCD_BAR_WORDS 3456
#define XB_SPIN_CAP (1u << 18)

__device__ __forceinline__ unsigned xb_ld(unsigned* p)              { return __hip_atomic_load(p, __ATOMIC_RELAXED, __HIP_MEMORY_SCOPE_AGENT); }
__device__ __forceinline__ unsigned xb_add(unsigned* p, unsigned v) { return __hip_atomic_fetch_add(p, v, __ATOMIC_RELAXED, __HIP_MEMORY_SCOPE_AGENT); }
__device__ __forceinline__ unsigned xb_xcc_id() { return (unsigned)__builtin_amdgcn_s_getreg((3 << 11) | 20) & 0xFu; }
#define XB_SPIN(cond, bar) do { unsigned _sp = 0; while (cond) { __builtin_amdgcn_s_sleep(1); \
    if ((++_sp & 255u) == 0u) { if (xb_ld(&(bar)[XB_TMO])) break; if (_sp > XB_SPIN_CAP) { atomicAdd(&(bar)[XB_TMO], 1u); break; } } } } while (0)

struct XcdBarrier {
    unsigned* bar; unsigned x;
    volatile LAS unsigned* st;
};

__device__ __forceinline__ XcdBarrier xcd_barrier_post(unsigned* bar, volatile LAS unsigned* st) {
    XcdBarrier b; b.bar = bar; b.x = xb_xcc_id(); b.st = st;
    if (threadIdx.x == 0) (void)xb_add(&bar[XB_XCNT(b.x)], 1u);
    return b;
}
__device__ __forceinline__ void xcd_barrier_complete(unsigned* bar, unsigned x, unsigned& nloc, unsigned& nx) {
    const unsigned G = gridDim.x * gridDim.y * gridDim.z;
    unsigned sum, cnt, mine, sp = 0u;
    for (;;) {
        sum = 0u; cnt = 0u; mine = 0u;
#pragma unroll
        for (unsigned j = 0; j < 16; ++j) { const unsigned c = xb_ld(&bar[XB_XCNT(j)]); sum += c; cnt += (c > 0u) ? 1u : 0u; mine = (j == x) ? c : mine; }
        if (sum == G) break;
        __builtin_amdgcn_s_sleep(1);
        if ((++sp & 255u) == 0u) { if (xb_ld(&bar[XB_TMO])) break; if (sp > XB_SPIN_CAP) { atomicAdd(&bar[XB_TMO], 1u); break; } }
    }
    nloc = mine > 0u ? mine : 1u; nx = cnt > 0u ? cnt : 1u;
}

__device__ __forceinline__ void xcd_barrier(const XcdBarrier& b) {
    asm volatile("s_waitcnt vmcnt(0)" ::: "memory");
    __syncthreads();
    if (threadIdx.x == 0) {
        unsigned* bar = b.bar;
        __builtin_amdgcn_s_waitcnt(0);
        unsigned nloc = b.st[0], nx = b.st[1];
        if (nloc == 0u) { xcd_barrier_complete(bar, b.x, nloc, nx); b.st[0] = nloc; b.st[1] = nx; }
        const unsigned old = xb_add(&bar[XB_XSUB(b.x)], 1u);
        const unsigned gen = old / nloc;
        if (old + 1u == (gen + 1u) * nloc) {
            __builtin_amdgcn_fence(__ATOMIC_RELEASE, "agent");
            asm volatile("s_waitcnt vmcnt(0)" ::: "memory");
            const unsigned og = xb_add(&bar[XB_TOP], 1u);
            const unsigned tg = og / nx;
            if (og + 1u == (tg + 1u) * nx) xb_add(&bar[XB_TOPGEN], 1u);
            else XB_SPIN(xb_ld(&bar[XB_TOPGEN]) == tg, bar);
            __builtin_amdgcn_fence(__ATOMIC_ACQUIRE, "agent");
            xb_add(&bar[XB_XGEN(b.x)], 1u);
            asm volatile("s_waitcnt vmcnt(0)" ::: "memory");
        } else {
            XB_SPIN(xb_ld(&bar[XB_XGEN(b.x)]) == gen, bar);
            __builtin_amdgcn_fence(__ATOMIC_ACQUIRE, "agent");
            asm volatile("s_waitcnt vmcnt(0)" ::: "memory");
        }
    }
    __syncthreads();
}
struct Frame {
    LAS unsigned char* lds;
    volatile LAS unsigned* MISC;
    gu32* ctl;
    int tid, lane, wave, vcu, G;
    const float *xp, *xs, *state, *norm1, *w_in, *w_s, *b_s, *norm_v, *lbl, *norm_o, *w_out, *norm2, *w_up, *w_dn, *norm_f;
    float* out;
    bf16 *Wt_in, *Wt_out, *Wt_up, *Wt_dn, *XN, *XN2, *U, *V, *Q, *LF, *I, *Gt, *HID;
};
template <int CTRL> __device__ __forceinline__ float dpp_f(float v) { return __builtin_bit_cast(float, __builtin_amdgcn_update_dpp(0, __builtin_bit_cast(int, v), CTRL, 0xf, 0xf, true)); }
__device__ __forceinline__ float sum8_dpp(float v) { v += dpp_f<0xB1>(v); v += dpp_f<0x4E>(v); v += dpp_f<0x141>(v); return v; }
__device__ __forceinline__ float wave_sum(float v) {
    v = sum8_dpp(v); v += dpp_f<0x140>(v);
    const int b = __builtin_bit_cast(int, v);
    return (__builtin_bit_cast(float, __builtin_amdgcn_readlane(b, 0)) + __builtin_bit_cast(float, __builtin_amdgcn_readlane(b, 16))) + (__builtin_bit_cast(float, __builtin_amdgcn_readlane(b, 32)) + __builtin_bit_cast(float, __builtin_amdgcn_readlane(b, 48)));
}
typedef __bf16 bf16x2_t __attribute__((ext_vector_type(2)));
__device__ __forceinline__ unsigned pkbf(float lo, float hi) { f32x2 v = {lo, hi}; bf16x2_t b = __builtin_convertvector(v, bf16x2_t); return __builtin_bit_cast(unsigned, b); }
__device__ __forceinline__ void p0_transpose_item(const float* W, int K, int N, bf16* WT, LAS unsigned char* scr, int item, int lane) {
    const int nblk = N / 64, kb = item / nblk, nb = item % nblk, k0 = 64 * kb, n0 = 64 * nb, kq = lane >> 4, n4 = 4 * (lane & 15);
    const GAS f32x4* wp = (const GAS f32x4*)(W + (size_t)(k0 + 16 * kq) * N + n0 + n4);
    const size_t rs = (size_t)(N / 4);
    f32x4 v[16];
#pragma unroll
    for (int i = 0; i < 16; ++i) v[i] = __builtin_nontemporal_load(wp + i * rs);
#pragma unroll
    for (int e = 0; e < 4; ++e) { v4u a, b;
        a.x = pkbf(v[0][e], v[1][e]); a.y = pkbf(v[2][e], v[3][e]); a.z = pkbf(v[4][e], v[5][e]); a.w = pkbf(v[6][e], v[7][e]);
        b.x = pkbf(v[8][e], v[9][e]); b.y = pkbf(v[10][e], v[11][e]); b.z = pkbf(v[12][e], v[13][e]); b.w = pkbf(v[14][e], v[15][e]);
        *(LAS v4u*)(scr + (n4 + e) * 144 + 32 * kq) = a; *(LAS v4u*)(scr + (n4 + e) * 144 + 32 * kq + 16) = b; }
    LDS_WAIT(); asm volatile("" ::: "memory");
    GAS unsigned char* op = (GAS unsigned char*)(WT + (size_t)(n0 + (lane >> 3)) * K + k0 + 8 * (lane & 7));
    const size_t os = (size_t)K * 2 * 8;
#pragma unroll
    for (int j = 0; j < 8; ++j) { const v4u o = *(const LAS v4u*)(scr + (8 * j + (lane >> 3)) * 144 + 16 * (lane & 7)); *(GAS v4u*)(op + j * os) = o; }
    LDS_WAIT(); asm volatile("" ::: "memory");
}
__device__ __forceinline__ void row_load(f32x4 (&v)[16], const float* xrow, int lane) { const GAS f32x4* xr = (const GAS f32x4*)xrow + lane;
#pragma unroll
    for (int j = 0; j < 16; ++j) v[j] = xr[64 * j]; }
__device__ __forceinline__ void row_load_nt(f32x4 (&v)[16], const float* xrow, int lane) { const GAS f32x4* xr = (const GAS f32x4*)xrow + lane;
#pragma unroll
    for (int j = 0; j < 16; ++j) v[j] = __builtin_nontemporal_load(xr + 64 * j); }
__device__ __forceinline__ void row_add_parts(f32x4 (&v)[16], const float* prow, int lane) {
#pragma unroll
    for (int ks = 0; ks < 8; ++ks) { const GAS f32x4* pr = (const GAS f32x4*)(prow + (size_t)ks * MS * DM) + lane;
#pragma unroll
        for (int j = 0; j < 16; ++j) v[j] = v[j] + pr[64 * j]; } }
__device__ __forceinline__ void row_store(const f32x4 (&v)[16], float* xrow, int lane) { GAS f32x4* xr = (GAS f32x4*)xrow + lane;
#pragma unroll
    for (int j = 0; j < 16; ++j) xr[64 * j] = v[j]; }
__device__ __forceinline__ float row_rstd(const f32x4 (&v)[16]) { float s = 0.f;
#pragma unroll
    for (int j = 0; j < 16; ++j) s += (v[j].x * v[j].x + v[j].y * v[j].y) + (v[j].z * v[j].z + v[j].w * v[j].w);
    return 1.0f / sqrtf(wave_sum(s) * (1.f / DM) + RMS_EPS); }
__device__ __forceinline__ void row_norm_to_bf16(const f32x4 (&v)[16], float r, const float* g, bf16* orow, int lane) {
    const GAS f32x4* gr = (const GAS f32x4*)g + lane; GAS v2u* o8 = (GAS v2u*)orow + lane;
#pragma unroll
    for (int j = 0; j < 16; ++j) { const f32x4 gg = gr[64 * j]; v2u o; o.x = pk2(v[j].x * r * gg.x, v[j].y * r * gg.y); o.y = pk2(v[j].z * r * gg.z, v[j].w * r * gg.w); o8[64 * j] = o; } }
__device__ __forceinline__ void row_norm_to_f32(const f32x4 (&v)[16], float r, const float* g, float* orow, int lane) {
    const GAS f32x4* gr = (const GAS f32x4*)g + lane; GAS f32x4* xr = (GAS f32x4*)orow + lane;
#pragma unroll
    for (int j = 0; j < 16; ++j) { const f32x4 gg = gr[64 * j]; __builtin_nontemporal_store((f32x4){v[j].x * r * gg.x, v[j].y * r * gg.y, v[j].z * r * gg.z, v[j].w * r * gg.w}, xr + 64 * j); } }
__device__ __forceinline__ float sample_row_sum(Frame& F, const float* baserow, const float* partrow, f32x4 (&v)[2]) {
    const GAS f32x4* bp = (const GAS f32x4*)baserow + 2 * F.tid; f32x4 p[8][2];
    v[0] = bp[0]; v[1] = bp[1];
#pragma unroll
    for (int ks = 0; ks < 8; ++ks) { const GAS f32x4* pp = (const GAS f32x4*)(partrow + (size_t)ks * MS * DM) + 2 * F.tid; p[ks][0] = __builtin_nontemporal_load(pp); p[ks][1] = __builtin_nontemporal_load(pp + 1); }
#pragma unroll
    for (int ks = 0; ks < 8; ++ks) { v[0] = v[0] + p[ks][0]; v[1] = v[1] + p[ks][1]; }
    float s = (v[0].x * v[0].x + v[0].y * v[0].y) + (v[0].z * v[0].z + v[0].w * v[0].w) + (v[1].x * v[1].x + v[1].y * v[1].y) + (v[1].z * v[1].z + v[1].w * v[1].w);
    s = wave_sum(s);
    LAS float* red = (LAS float*)(F.lds + RING_OFF);
    __syncthreads();
    if (F.lane == 0) red[F.wave] = s;
    __syncthreads();
    return ((red[0] + red[1]) + (red[2] + red[3])) + ((red[4] + red[5]) + (red[6] + red[7]));
}
__device__ __forceinline__ void p0_prologue(Frame& F) {
    LAS unsigned char* scr = F.lds + RING_OFF + F.wave * 16384;
    const int gw = F.vcu * NWAVES + F.wave, NGW = F.G * NWAVES;
    constexpr int I_IN = (DM / 64) * (NIN / 64);
    for (int it = gw; it < I_IN; it += NGW) p0_transpose_item(F.w_in, DM, NIN, F.Wt_in, scr, it, F.lane);
    for (int m = gw; m < MT; m += NGW) { f32x4 v[16]; row_load_nt(v, m < MP ? F.xp + (size_t)m * DM : F.xs + (size_t)(m - MP) * DM, F.lane); row_norm_to_bf16(v, row_rstd(v), F.norm1, F.XN + (size_t)m * DM, F.lane); }
}
constexpr int CV_OUT = (DM / 64) * (DM / 64), CV_UP = (DM / 64) * (DFF / 64), CV_DN = (DFF / 64) * (DM / 64), CV_ALL = CV_OUT + CV_UP + CV_DN;
constexpr int CV_TAIL1 = 12288;
constexpr int CV_TAIL2_LO = CV_OUT + CV_UP, CV_TAIL2_HI = CV_OUT + CV_UP + 9216;
template <int NW = NWAVES> __device__ __forceinline__ void convert_items(Frame& F, int lo, int hi, int rank, int n_wgs) {
    if (rank < 0 || lo >= hi) return;
    LAS unsigned char* scr = F.lds + RING_OFF + F.wave * 16384;
    __syncthreads();
    if (F.wave < NW) for (int it = lo + rank * NW + F.wave; it < hi; it += n_wgs * NW) {
        int r = it;
        if (r < CV_OUT) { p0_transpose_item(F.w_out, DM, DM, F.Wt_out, scr, r, F.lane); continue; } r -= CV_OUT;
        if (r < CV_UP) { p0_transpose_item(F.w_up, DM, DFF, F.Wt_up, scr, r, F.lane); continue; } r -= CV_UP;
        p0_transpose_item(F.w_dn, DFF, DM, F.Wt_dn, scr, r, F.lane);
    }
    __syncthreads();
}
typedef short bf16x8_t __attribute__((ext_vector_type(8)));
struct GUnit { int row0, h, L, sidx; };
__device__ __forceinline__ GUnit gmlp_unit(int u) { GUnit q; if (u < 1024) { const int b = u >> 8, n = (u >> 3) & 31; q.h = u & 7; q.row0 = b * 4096 + n * 128; q.L = 128; q.sidx = -1; } else { const int s = (u - 1024) >> 3; q.h = u & 7; q.row0 = MP + s * 16; q.L = 16; q.sidx = s; } return q; }
struct GRaw { v2u v[2][8]; v2u gu[8][2]; float bias[8]; f32x4 gain; };
__device__ __forceinline__ void gmlp_load(const Frame& F, GRaw& R, const GUnit& q) {
    const int lane = F.lane, wave = F.wave, fr = lane & 15, fq = lane >> 4, ntg = q.L >> 3, nit = (q.L == 16) ? 1 : 8;
#pragma unroll
    for (int g2 = 0; g2 < 2; ++g2) { const int tg = wave + 8 * g2;
        if (tg < ntg) { const GAS v2u* vp = (const GAS v2u*)(F.V + (size_t)(q.row0 + 8 * tg) * 2048 + q.h * 256 + 4 * lane);
#pragma unroll
            for (int r = 0; r < 8; ++r) R.v[g2][r] = __builtin_nontemporal_load(vp + r * 512); }
        else {
#pragma unroll
            for (int r = 0; r < 8; ++r) R.v[g2][r] = (v2u){0u, 0u}; } }
    const GAS v2u* up = (const GAS v2u*)(F.U + (size_t)(q.row0 + fr) * 2048 + q.h * 256 + 32 * wave + 4 * fq);
    const GAS float* bp = (const GAS float*)(F.b_s + q.h * 128 + fr);
#pragma unroll
    for (int it = 0; it < 8; ++it) { if (it < nit) { R.gu[it][0] = __builtin_nontemporal_load(up + it * 16 * 512); R.gu[it][1] = __builtin_nontemporal_load(up + it * 16 * 512 + 4); R.bias[it] = bp[16 * it]; } else { R.gu[it][0] = (v2u){0u, 0u}; R.gu[it][1] = R.gu[it][0]; R.bias[it] = 0.f; } }
    R.gain = *(const GAS f32x4*)(F.norm_v + q.h * 256 + 4 * lane);
}
__device__ __forceinline__ void gmlp_mfma(Frame& F) {
    constexpr int WSTR = 272, VSTR = 272;
    LAS unsigned char* WB = F.lds + RING_OFF;
    LAS unsigned char* VT = F.lds + RING_OFF + 128 * WSTR;
    const int tid = F.tid, lane = F.lane, wave = F.wave, fr = lane & 15, fq = lane >> 4;
    bf16* Y = F.XN;
    int last_h = -1;
    const int gu0 = (F.G > NHEAVY) ? ((int)blockIdx.x < NHEAVY ? 1280 : (int)blockIdx.x - NHEAVY) : (int)blockIdx.x, gstep = (F.G > NHEAVY) ? F.G - NHEAVY : F.G;
    GRaw cur;
    if (gu0 < 1280) gmlp_load(F, cur, gmlp_unit(gu0));
    for (int u = gu0; u < 1280; u += gstep) {
        const GUnit q = gmlp_unit(u); const int row0 = q.row0, h = q.h, L = q.L, sidx = q.sidx;
        const int ntg = L >> 3, nit = (L == 16) ? 1 : 8;
        GRaw nxt;
        if (u + gstep < 1280) gmlp_load(F, nxt, gmlp_unit(u + gstep));
        else nxt = cur;
        LBAR();
        if (h != last_h) {
            const int i = tid >> 2, j0 = (tid & 3) * 32;
            const GAS f32x4* wp = (const GAS f32x4*)(F.w_s + ((size_t)h * 128 + i) * 128 + j0);
            const bool keep = !(i < 64 && j0 >= 64);
#pragma unroll
            for (int c = 0; c < 4; ++c) { const f32x4 a = wp[2 * c], b = wp[2 * c + 1]; v4u o;
                o.x = keep ? pkbf(a.x, a.y) : 0u; o.y = keep ? pkbf(a.z, a.w) : 0u; o.z = keep ? pkbf(b.x, b.y) : 0u; o.w = keep ? pkbf(b.z, b.w) : 0u;
                *(LAS v4u*)(WB + i * WSTR + (j0 + 8 * c) * 2) = o; }
            last_h = h;
        }
#pragma unroll
        for (int g2 = 0; g2 < 2; ++g2) { const int tg = wave + 8 * g2;
            if (tg < ntg) {
                float x[8][4], ss[8];
#pragma unroll
                for (int r = 0; r < 8; ++r) { const v2u raw = cur.v[g2][r]; x[r][0] = bf2f(raw.x & 0xffffu); x[r][1] = bf2f(raw.x >> 16); x[r][2] = bf2f(raw.y & 0xffffu); x[r][3] = bf2f(raw.y >> 16);
                    ss[r] = (x[r][0] * x[r][0] + x[r][1] * x[r][1]) + (x[r][2] * x[r][2] + x[r][3] * x[r][3]); }
#pragma unroll
                for (int r = 0; r < 8; ++r) ss[r] = wave_sum(ss[r]);
#pragma unroll
                for (int r = 0; r < 8; ++r) { const float rs = 1.0f / sqrtf(ss[r] * (1.f / 256.f) + RMS_EPS);
                    x[r][0] *= rs * cur.gain.x; x[r][1] *= rs * cur.gain.y; x[r][2] *= rs * cur.gain.z; x[r][3] *= rs * cur.gain.w; }
                if (sidx >= 0) { GAS f32x4* op = (GAS f32x4*)(F.out + OUT_VS + (size_t)(sidx * 16 + 8 * tg) * 2048 + h * 256 + 4 * lane);
#pragma unroll
                    for (int r = 0; r < 8; ++r) op[r * 512] = (f32x4){x[r][0], x[r][1], x[r][2], x[r][3]}; }
#pragma unroll
                for (int e = 0; e < 4; ++e) { v4u o; o.x = pkbf(x[0][e], x[1][e]); o.y = pkbf(x[2][e], x[3][e]); o.z = pkbf(x[4][e], x[5][e]); o.w = pkbf(x[6][e], x[7][e]);
                    *(LAS v4u*)(VT + (4 * lane + e) * VSTR + 16 * tg) = o; }
            } else if (L == 16 && tg < 4) {
#pragma unroll
                for (int e = 0; e < 4; ++e) *(LAS v4u*)(VT + (4 * lane + e) * VSTR + 16 * tg) = (v4u){0u, 0u, 0u, 0u};
            }
        }
        LBAR();
        bf16x8_t a[2][4];
#pragma unroll
        for (int dt = 0; dt < 2; ++dt)
#pragma unroll
            for (int ks = 0; ks < 4; ++ks) a[dt][ks] = *(const LAS bf16x8_t*)(VT + (32 * wave + 16 * dt + fr) * VSTR + (32 * ks + 8 * fq) * 2);
        GAS v2u* yp = (GAS v2u*)(Y + (size_t)(row0 + fr) * DM + h * 256 + 32 * wave + 4 * fq);
#pragma unroll
        for (int it = 0; it < 8; ++it) {
            if (it < nit) {
                const int nks = (L == 16) ? 1 : (it < 4 ? 2 : 4);
                bf16x8_t b[4];
#pragma unroll
                for (int ks = 0; ks < 4; ++ks) b[ks] = *(const LAS bf16x8_t*)(WB + (16 * it + fr) * WSTR + (32 * ks + 8 * fq) * 2);
                f32x4 acc0 = (f32x4){0.f, 0.f, 0.f, 0.f}, acc1 = (f32x4){0.f, 0.f, 0.f, 0.f};
#pragma unroll
                for (int ks = 0; ks < 4; ++ks) {
                    if (ks < nks) { acc0 = __builtin_amdgcn_mfma_f32_16x16x32_bf16(a[0][ks], b[ks], acc0, 0, 0, 0); acc1 = __builtin_amdgcn_mfma_f32_16x16x32_bf16(a[1][ks], b[ks], acc1, 0, 0, 0); }
                }
                const float bias = cur.bias[it];
#pragma unroll
                for (int dt = 0; dt < 2; ++dt) { const f32x4 acc = dt ? acc1 : acc0; const v2u g = cur.gu[it][dt]; v2u o;
                    o.x = pkbf((acc.x + bias) * bf2f(g.x & 0xffffu), (acc.y + bias) * bf2f(g.x >> 16)); o.y = pkbf((acc.z + bias) * bf2f(g.y & 0xffffu), (acc.w + bias) * bf2f(g.y >> 16));
                    yp[it * 16 * (DM / 4) + 4 * dt] = o; }
            }
        }
        cur = nxt;
    }
    __syncthreads();
}
struct HRaw { unsigned q[8], f[8], i[8]; };
__device__ __forceinline__ void hgrn_load_raw(const Frame& F, HRaw& R, int row, int h, int valid) {
    const int t0 = 8 * F.wave;
    if (t0 < valid) {
#pragma unroll
        for (int r = 0; r < 8; ++r) { const size_t rb = (size_t)(row + t0 + r) * 2048 + h * 128 + 2 * F.lane;
            R.q[r] = __builtin_nontemporal_load((const GAS unsigned*)(F.Q + rb)); R.f[r] = __builtin_nontemporal_load((const GAS unsigned*)(F.LF + rb)); R.i[r] = __builtin_nontemporal_load((const GAS unsigned*)(F.I + rb)); }
    } else {
#pragma unroll
        for (int r = 0; r < 8; ++r) { R.q[r] = 0u; R.f[r] = 0x3C003C00u; R.i[r] = 0u; }
    }
}
__device__ __forceinline__ void hgrn_load_g(const Frame& F, v4u (&g)[2], int row, int h, int valid) {
    const int t = F.tid >> 3;
    if (8 * F.wave < valid) { const GAS v4u* gp = (const GAS v4u*)(F.Gt + (size_t)(row + t) * 2048 + h * 128 + 16 * (F.tid & 7)); g[0] = __builtin_nontemporal_load(gp); g[1] = __builtin_nontemporal_load(gp + 1); }
    else { g[0] = (v4u){0u, 0u, 0u, 0u}; g[1] = g[0]; }
}
__device__ __forceinline__ void hgrn_mfma(Frame& F) {
    constexpr int QSTR = 272, TSTR = 144, OSTR = 528;
    constexpr int L_QE = 0, L_QR = 17408, L_KR = 34816, L_KET = 52224, L_IT = 70656, L_P = 89088, L_TOT = 98304, L_PEND = 102912, L_NO = 103424, L_OS = 103936;
    static_assert(L_OS + 64 * OSTR <= LDSCTL_OFF, "HGRN2 LDS map");
    LAS unsigned char* const B0 = F.lds;
    const int lane = F.lane, wave = F.wave, fr = lane & 15, fq = lane >> 4, G = F.G, bx = (int)blockIdx.x;
    bf16* Y = F.XN;
    int u0, ustep; if (G > NHEAVY) { if (bx < NHEAVY) { u0 = bx; ustep = 1 << 20; } else { u0 = bx; ustep = G - NHEAVY; } } else { u0 = bx; ustep = G; }
    for (int u = u0; u < NHEAVY + 512; u += ustep) {
        int row0, nch, nfull, h, valid; const float* s0; float* sout;
        if (u < NHEAVY) { const int bh = u & 63, seg = u >> 6, b = bh >> 4; h = bh & 15; row0 = b * 4096; nch = seg ? 64 : HSPLIT; nfull = seg ? HSPLIT : 0; valid = 64; s0 = nullptr; sout = seg ? F.out + OUT_SP + (size_t)bh * 16384 : nullptr; }
        else { const int su = u - NHEAVY; h = su & 15; row0 = MP + (su >> 4) * 16; nch = 1; nfull = 0; valid = 16; s0 = F.state + (size_t)su * 16384; sout = F.out + OUT_SS + (size_t)su * 16384; }
        f32x4 S[8];
        if (s0) {
            const GAS float* sp = (const GAS float*)s0 + (4 * fq) * 128 + 16 * wave + fr;
#pragma unroll
            for (int dt = 0; dt < 8; ++dt)
#pragma unroll
                for (int e = 0; e < 4; ++e) S[dt][e] = sp[(16 * dt + e) * 128];
        } else {
#pragma unroll
            for (int dt = 0; dt < 8; ++dt) S[dt] = (f32x4){0.f, 0.f, 0.f, 0.f};
        }
        if (F.tid < 32) *(LAS f32x4*)(B0 + L_NO + 16 * F.tid) = *(const GAS f32x4*)(F.norm_o + h * 128 + 4 * F.tid);
        HRaw cur, nx1; v4u gcur[2], gnxt[2];
        hgrn_load_raw(F, cur, row0, h, valid); hgrn_load_g(F, gnxt, row0, h, valid);
        if (nch > 1) hgrn_load_raw(F, nx1, row0 + 64, h, valid); else nx1 = cur;
        gcur[0] = gnxt[0]; gcur[1] = gnxt[1];
        for (int n = -1; n < nch; ++n) {
            const bool has_cur = n >= 0, has_next = n + 1 < nch, full_cur = n >= nfull, full_next = has_next && n + 1 >= nfull;
            const int rowc = row0 + 64 * n;
            if (has_next) {
                float t0 = h2f(cur.f[0] & 0xffffu), t1 = h2f(cur.f[0] >> 16);
                if (wave == 4) *(LAS f32x2*)(B0 + L_TOT + (8 * 128 + 2 * lane) * 4) = (f32x2){t0, t1};
#pragma unroll
                for (int r = 1; r < 8; ++r) { t0 *= h2f(cur.f[r] & 0xffffu); t1 *= h2f(cur.f[r] >> 16); }
                *(LAS f32x2*)(B0 + L_TOT + (wave * 128 + 2 * lane) * 4) = (f32x2){t0, t1};
            }
            if (has_cur) {
                bf16x8_t bi[2];
#pragma unroll
                for (int ks = 0; ks < 2; ++ks) bi[ks] = *(const LAS bf16x8_t*)(B0 + L_IT + (16 * wave + fr) * TSTR + (32 * ks + 8 * fq) * 2);
                f32x4 o[4];
                if (full_cur) {
                    bf16x8_t sb[4];
#pragma unroll
                    for (int ks = 0; ks < 4; ++ks) { v4u p; p.x = pkbf(S[2 * ks][0], S[2 * ks][1]); p.y = pkbf(S[2 * ks][2], S[2 * ks][3]); p.z = pkbf(S[2 * ks + 1][0], S[2 * ks + 1][1]); p.w = pkbf(S[2 * ks + 1][2], S[2 * ks + 1][3]);
                        sb[ks] = __builtin_bit_cast(bf16x8_t, p); }
                    bf16x8_t pa[6]; v2u qlo[2][4], qhi[2][4];
                    pa[0] = *(const LAS bf16x8_t*)(B0 + L_P + (fr) * TSTR + (8 * fq) * 2); pa[1] = *(const LAS bf16x8_t*)(B0 + L_P + (16 + fr) * TSTR + (8 * fq) * 2);
                    pa[2] = *(const LAS bf16x8_t*)(B0 + L_P + (32 + fr) * TSTR + (8 * fq) * 2); pa[3] = *(const LAS bf16x8_t*)(B0 + L_P + (32 + fr) * TSTR + (32 + 8 * fq) * 2);
                    pa[4] = *(const LAS bf16x8_t*)(B0 + L_P + (48 + fr) * TSTR + (8 * fq) * 2); pa[5] = *(const LAS bf16x8_t*)(B0 + L_P + (48 + fr) * TSTR + (32 + 8 * fq) * 2);
                    SCHED_FENCE();
                    const f32x4 z4 = (f32x4){0.f, 0.f, 0.f, 0.f};
                    o[0] = __builtin_amdgcn_mfma_f32_16x16x32_bf16(pa[0], bi[0], z4, 0, 0, 0); o[1] = __builtin_amdgcn_mfma_f32_16x16x32_bf16(pa[1], bi[0], z4, 0, 0, 0);
                    o[2] = __builtin_amdgcn_mfma_f32_16x16x32_bf16(pa[2], bi[0], z4, 0, 0, 0); o[3] = __builtin_amdgcn_mfma_f32_16x16x32_bf16(pa[4], bi[0], z4, 0, 0, 0);
                    o[2] = __builtin_amdgcn_mfma_f32_16x16x32_bf16(pa[3], bi[1], o[2], 0, 0, 0); o[3] = __builtin_amdgcn_mfma_f32_16x16x32_bf16(pa[5], bi[1], o[3], 0, 0, 0);
                    SCHED_FENCE();
#pragma unroll
                    for (int hf = 0; hf < 2; ++hf) {
#pragma unroll
                        for (int tt = 0; tt < 2; ++tt)
#pragma unroll
                            for (int ks = 0; ks < 4; ++ks) { qlo[tt][ks] = *(const LAS v2u*)(B0 + L_QE + (32 * hf + 16 * tt + fr) * QSTR + (32 * ks + 4 * fq) * 2); qhi[tt][ks] = *(const LAS v2u*)(B0 + L_QE + (32 * hf + 16 * tt + fr) * QSTR + (32 * ks + 16 + 4 * fq) * 2); }
                        SCHED_FENCE();
#pragma unroll
                        for (int ks = 0; ks < 4; ++ks)
#pragma unroll
                            for (int tt = 0; tt < 2; ++tt) o[2 * hf + tt] = __builtin_amdgcn_mfma_f32_16x16x32_bf16(__builtin_bit_cast(bf16x8_t, (v4u){qlo[tt][ks].x, qlo[tt][ks].y, qhi[tt][ks].x, qhi[tt][ks].y}), sb[ks], o[2 * hf + tt], 0, 0, 0);
                        SCHED_FENCE();
                    }
                }
                {
                    f32x4 pe[8];
#pragma unroll
                    for (int dt = 0; dt < 8; ++dt) pe[dt] = *(const LAS f32x4*)(B0 + L_PEND + (16 * dt + 4 * fq) * 4);
#pragma unroll
                    for (int dt = 0; dt < 8; ++dt) S[dt] = S[dt] * pe[dt];
                }
                SCHED_FENCE();
#pragma unroll
                for (int hf = 0; hf < 2; ++hf) {
                    bf16x8_t ka[4][2];
#pragma unroll
                    for (int dt = 0; dt < 4; ++dt)
#pragma unroll
                        for (int ks = 0; ks < 2; ++ks) ka[dt][ks] = *(const LAS bf16x8_t*)(B0 + L_KET + (64 * hf + 16 * dt + fr) * TSTR + (32 * ks + 8 * fq) * 2);
                    SCHED_FENCE();
#pragma unroll
                    for (int ks = 0; ks < 2; ++ks)
#pragma unroll
                        for (int dt = 0; dt < 4; ++dt) S[4 * hf + dt] = __builtin_amdgcn_mfma_f32_16x16x32_bf16(ka[dt][ks], bi[ks], S[4 * hf + dt], 0, 0, 0);
                    SCHED_FENCE();
                }
                if (full_cur) {
#pragma unroll
                    for (int tt = 0; tt < 4; ++tt)
#pragma unroll
                        for (int e = 0; e < 4; ++e) *(LAS float*)(B0 + L_OS + (16 * tt + 4 * fq + e) * OSTR + (16 * wave + fr) * 4) = o[tt][e];
                }
            }
            LBAR();
            if (has_cur && full_cur) {
                const int t = F.tid >> 3, vg = F.tid & 7;
                f32x4 ov[4], no[4]; float ss = 0.f;
#pragma unroll
                for (int j = 0; j < 4; ++j) no[j] = *(const LAS f32x4*)(B0 + L_NO + 64 * vg + 16 * j);
#pragma unroll
                for (int j = 0; j < 4; ++j) { ov[j] = *(const LAS f32x4*)(B0 + L_OS + t * OSTR + 64 * vg + 16 * j); ss += (ov[j].x * ov[j].x + ov[j].y * ov[j].y) + (ov[j].z * ov[j].z + ov[j].w * ov[j].w); }
                ss = sum8_dpp(ss);
                const float rs = __builtin_amdgcn_rsqf(ss * (1.f / 128.f) + RMS_EPS);
                v4u y[2];
#pragma unroll
                for (int j = 0; j < 2; ++j) { const v4u g = gcur[j]; const f32x4 a = ov[2 * j] * no[2 * j] * rs, b = ov[2 * j + 1] * no[2 * j + 1] * rs;
                    y[j].x = pkbf(a.x * bf2f(g.x & 0xffffu), a.y * bf2f(g.x >> 16)); y[j].y = pkbf(a.z * bf2f(g.y & 0xffffu), a.w * bf2f(g.y >> 16));
                    y[j].z = pkbf(b.x * bf2f(g.z & 0xffffu), b.y * bf2f(g.z >> 16)); y[j].w = pkbf(b.z * bf2f(g.w & 0xffffu), b.w * bf2f(g.w >> 16)); }
                if (8 * wave < valid) { GAS v4u* yp = (GAS v4u*)(Y + (size_t)(rowc + t) * DM + 2048 + h * 128 + 16 * vg); yp[0] = y[0]; yp[1] = y[1]; }
            }
            if (has_next) {
                f32x2 tv[9];
#pragma unroll
                for (int w = 0; w < 9; ++w) tv[w] = *(const LAS f32x2*)(B0 + L_TOT + (w * 128 + 2 * lane) * 4);
                f32x2 off = (f32x2){1.f, 1.f}, pend = (f32x2){1.f, 1.f};
#pragma unroll
                for (int w = 0; w < 8; ++w) { if (w < wave) off = off * tv[w]; pend = pend * tv[w]; }
                const f32x2 p32 = tv[0] * tv[1] * tv[2] * tv[3] * tv[8];
                const f32x2 ip32 = (f32x2){__builtin_amdgcn_rcpf(p32.x), __builtin_amdgcn_rcpf(p32.y)};
                if (wave == 0) *(LAS f32x2*)(B0 + L_PEND + 8 * lane) = pend;
                float ke0[8], ke1[8]; float P0 = off.x, P1 = off.y;
#pragma unroll
                for (int r = 0; r < 8; ++r) {
                    P0 *= h2f(cur.f[r] & 0xffffu); P1 *= h2f(cur.f[r] >> 16);
                    const float r0 = __builtin_amdgcn_rcpf(P0), r1 = __builtin_amdgcn_rcpf(P1);
                    const float qe0 = bf2f(cur.q[r] & 0xffffu) * P0, qe1 = bf2f(cur.q[r] >> 16) * P1;
                    const float kk0 = (1.0f - h2f(cur.f[r] & 0xffffu)) * r0, kk1 = (1.0f - h2f(cur.f[r] >> 16)) * r1;
                    const int ro = (8 * wave + r) * QSTR + 4 * lane;
                    if (full_next) {
                        *(LAS unsigned*)(B0 + L_QE + ro) = pkbf(qe0, qe1);
                        *(LAS unsigned*)(B0 + L_QR + ro) = pkbf(qe0 * ip32.x, qe1 * ip32.y);
                        *(LAS unsigned*)(B0 + L_KR + ro) = pkbf(kk0 * p32.x, kk1 * p32.y); }
                    ke0[r] = kk0 * pend.x; ke1[r] = kk1 * pend.y;
                }
                v4u a, b, c, d;
                a.x = pkbf(ke0[0], ke0[1]); a.y = pkbf(ke0[2], ke0[3]); a.z = pkbf(ke0[4], ke0[5]); a.w = pkbf(ke0[6], ke0[7]);
                b.x = pkbf(ke1[0], ke1[1]); b.y = pkbf(ke1[2], ke1[3]); b.z = pkbf(ke1[4], ke1[5]); b.w = pkbf(ke1[6], ke1[7]);
                c.x = (cur.i[0] & 0xffffu) | (cur.i[1] << 16); c.y = (cur.i[2] & 0xffffu) | (cur.i[3] << 16); c.z = (cur.i[4] & 0xffffu) | (cur.i[5] << 16); c.w = (cur.i[6] & 0xffffu) | (cur.i[7] << 16);
                d.x = (cur.i[0] >> 16) | (cur.i[1] & 0xffff0000u); d.y = (cur.i[2] >> 16) | (cur.i[3] & 0xffff0000u); d.z = (cur.i[4] >> 16) | (cur.i[5] & 0xffff0000u); d.w = (cur.i[6] >> 16) | (cur.i[7] & 0xffff0000u);
                *(LAS v4u*)(B0 + L_KET + (2 * lane) * TSTR + 16 * wave) = a; *(LAS v4u*)(B0 + L_KET + (2 * lane + 1) * TSTR + 16 * wave) = b;
                *(LAS v4u*)(B0 + L_IT + (2 * lane) * TSTR + 16 * wave) = c; *(LAS v4u*)(B0 + L_IT + (2 * lane + 1) * TSTR + 16 * wave) = d;
            }
            LBAR();
            if (has_next) {
                cur = nx1;
                if (n + 3 < nch) hgrn_load_raw(F, nx1, rowc + 192, h, valid);
                gcur[0] = gnxt[0]; gcur[1] = gnxt[1];
                if (n + 2 < nch) hgrn_load_g(F, gnxt, rowc + 128, h, valid);
                if (full_next) {
                const int tt = wave >> 1, st0 = 2 * (wave & 1);
                bf16x8_t ka[2][4], qb[4];
#pragma unroll
                for (int ks = 0; ks < 4; ++ks) { qb[ks] = *(const LAS bf16x8_t*)(B0 + L_QR + (16 * tt + fr) * QSTR + (32 * ks + 8 * fq) * 2);
                    ka[0][ks] = *(const LAS bf16x8_t*)(B0 + L_KR + (16 * st0 + fr) * QSTR + (32 * ks + 8 * fq) * 2); ka[1][ks] = *(const LAS bf16x8_t*)(B0 + L_KR + (16 * st0 + 16 + fr) * QSTR + (32 * ks + 8 * fq) * 2); }
                SCHED_FENCE();
                f32x4 acc0 = (f32x4){0.f, 0.f, 0.f, 0.f}, acc1 = acc0;
#pragma unroll
                for (int ks = 0; ks < 4; ++ks) { acc0 = __builtin_amdgcn_mfma_f32_16x16x32_bf16(ka[0][ks], qb[ks], acc0, 0, 0, 0); acc1 = __builtin_amdgcn_mfma_f32_16x16x32_bf16(ka[1][ks], qb[ks], acc1, 0, 0, 0); }
#pragma unroll
                for (int e = 0; e < 4; ++e) { const int t = 16 * tt + fr; if (16 * st0 + 4 * fq + e > t) acc0[e] = 0.f; if (16 * st0 + 16 + 4 * fq + e > t) acc1[e] = 0.f; }
                *(LAS v2u*)(B0 + L_P + (16 * tt + fr) * TSTR + (16 * st0 + 4 * fq) * 2) = (v2u){pkbf(acc0.x, acc0.y), pkbf(acc0.z, acc0.w)};
                *(LAS v2u*)(B0 + L_P + (16 * tt + fr) * TSTR + (16 * st0 + 16 + 4 * fq) * 2) = (v2u){pkbf(acc1.x, acc1.y), pkbf(acc1.z, acc1.w)};
                LBAR();
                }
            }
        }
        if (sout) { GAS float* sp = (GAS float*)sout + (4 * fq) * 128 + 16 * wave + fr;
#pragma unroll
          for (int dt = 0; dt < 8; ++dt)
#pragma unroll
              for (int e = 0; e < 4; ++e) sp[(16 * dt + e) * 128] = S[dt][e]; }
        __syncthreads();
    }
}
struct Args { const float* in[15]; float* out; unsigned char* ws; int ph_lo, ph_hi, li, pad; };
__global__ void __launch_bounds__(NWAVES * 64, 2) fwd_kernel(Args args) {
    extern __shared__ __attribute__((aligned(16))) unsigned char lds[];
    Frame F;
    F.lds = (LAS unsigned char*)lds;
    F.MISC = (volatile LAS unsigned*)(F.lds + MISC_OFF);
    F.tid = threadIdx.x; F.lane = F.tid & 63; F.wave = __builtin_amdgcn_readfirstlane(F.tid >> 6);
    F.G = gridDim.x; { const int bx = blockIdx.x; F.vcu = (F.G % 8 == 0) ? (bx % 8) * (F.G / 8) + bx / 8 : bx; }
    unsigned char* ws = args.ws;
    F.ctl = (gu32*)(ws + WS_CTL);
    F.xp = args.in[0]; F.xs = args.in[1]; F.state = args.in[2]; F.norm1 = args.in[3]; F.w_in = args.in[4]; F.w_s = args.in[5]; F.b_s = args.in[6]; F.norm_v = args.in[7];
    F.lbl = args.in[8]; F.norm_o = args.in[9]; F.w_out = args.in[10]; F.norm2 = args.in[11]; F.w_up = args.in[12]; F.w_dn = args.in[13]; F.norm_f = args.in[14];
    F.out = args.out;
    F.Wt_in = (bf16*)(ws + WS_WIN); F.Wt_out = (bf16*)(ws + WS_WOUT); F.Wt_up = (bf16*)(ws + WS_WUP); F.Wt_dn = (bf16*)(ws + WS_WDN);
    F.XN = (bf16*)(ws + WS_XN); F.XN2 = (bf16*)(ws + WS_XN2);
    F.U = (bf16*)(ws + WS_P); F.V = (bf16*)(ws + WS_P + P_STRIDE); F.Q = (bf16*)(ws + WS_P + 2 * P_STRIDE); F.LF = (bf16*)(ws + WS_P + 3 * P_STRIDE);
    F.I = (bf16*)(ws + WS_P + 4 * P_STRIDE); F.Gt = (bf16*)(ws + WS_P + 5 * P_STRIDE); F.HID = (bf16*)(ws + WS_HID);
    for (int u = F.tid; u < (LDS_BYTES - LDSCTL_OFF) / 4; u += NWAVES * 64) ((LAS unsigned*)(F.lds + LDSCTL_OFF))[u] = 0u;
    __syncthreads();
    XcdBarrier bar; bar.bar = (unsigned*)(F.ctl + CW_BAR); bar.x = 0; bar.st = nullptr;
    if (N_LAUNCHES != NPHASES) bar = xcd_barrier_post((unsigned*)(F.ctl + CW_BAR), F.MISC + 8);
#define GRID_BAR() do { if (N_LAUNCHES == NPHASES) { if (F.tid == 0) __hip_atomic_store(F.ctl + 0, 0xBADBA0u, RLX_AGENT); } else { xcd_barrier(bar); } } while (0)
    const int lo = args.ph_lo, hi = args.ph_hi;
#define IN(k) (lo <= (k) && (k) < hi)
#define BOTH(k) (IN(k) && IN((k) + 1))

    if (IN(0)) { p0_prologue(F); if (BOTH(0)) GRID_BAR(); }
    if (IN(1)) {
        pg8::Gemm g{F.XN, F.Wt_in, MT, NIN, DM, DM}; pg8::StaticOrder S; S.init(MT, NIN, F.G, (int)blockIdx.x);
        pg8::EpiProj E{F.U, F.lbl};
        pg8::gemm_phase<pg8::EpiProj, pg8::StaticOrder, true, true>(F.lds + RING_OFF, g, S, E);
        if (F.G == 256) convert_items(F, 0, CV_TAIL1, (int)blockIdx.x - (MT / 256 * (NIN / 256) - 12 * 256), 256 - (MT / 256 * (NIN / 256) - 12 * 256));
        if (BOTH(1)) GRID_BAR();
    }
    if (IN(2)) { gmlp_mfma(F); hgrn_mfma(F);
        { const int nl = (F.G > NHEAVY) ? F.G - NHEAVY : F.G, lid = (F.G > NHEAVY) ? (int)blockIdx.x - NHEAVY : (int)blockIdx.x; const bool tails = (F.G == 256);
          convert_items<2>(F, tails ? CV_TAIL1 : 0, tails ? CV_TAIL2_LO : CV_ALL, lid, nl); if (tails) convert_items<2>(F, CV_TAIL2_HI, CV_ALL, lid, nl); }
        if (BOTH(2)) GRID_BAR(); }
    if (IN(3)) { if (BOTH(3)) GRID_BAR(); }
    if (IN(4)) {
        { pg8::Gemm g{F.XN, F.Wt_out, MP, DM, DM, DM}; pg8::StaticOrder S; S.init(MP, DM, F.G, (int)blockIdx.x);
          pg8::EpiResNorm E{F.xp, F.out + OUT_Y, F.XN2, F.norm2, (float*)(ws + WS_CTL + CTL_SSQ), F.G != 256};
          pg8::gemm_phase<pg8::EpiResNorm, pg8::StaticOrder, true, true>(F.lds + RING_OFF, g, S, E); }
        { pg8::Gemm g{F.XN, F.Wt_out, MT, DM, DM / 8, DM}; pg8::SplitOrder S; S.init(MP / 256, MS / 256, DM, 8, DM / 8, F.G, (int)blockIdx.x);
          pg8::EpiPart E{(float*)(ws + WS_PART1), DM / 8};
          pg8::gemm_phase<pg8::EpiPart, pg8::SplitOrder, true, true>(F.lds + RING_OFF, g, S, E); }
        if (BOTH(4)) GRID_BAR();
    }
    if (IN(5)) {
        float* ssq = (float*)(ws + WS_CTL + CTL_SSQ);
        for (int m = MP + (int)blockIdx.x; m < MT; m += F.G) {
            f32x4 v[2]; const float s = sample_row_sum(F, F.xs + (size_t)(m - MP) * DM, (const float*)(ws + WS_PART1) + (size_t)(m - MP) * DM, v);
            GAS f32x4* xo = (GAS f32x4*)(F.out + OUT_Y + (size_t)m * DM) + 2 * F.tid; xo[0] = v[0]; xo[1] = v[1];
            if (F.tid == 0) ssq[m] = s;
            const GAS f32x4* gp = (const GAS f32x4*)F.norm2 + 2 * F.tid; const f32x4 g0 = gp[0], g1 = gp[1];
            v4u o; o.x = pk2(v[0].x * g0.x, v[0].y * g0.y); o.y = pk2(v[0].z * g0.z, v[0].w * g0.w); o.z = pk2(v[1].x * g1.x, v[1].y * g1.y); o.w = pk2(v[1].z * g1.z, v[1].w * g1.w);
            *((GAS v4u*)(F.XN2 + (size_t)m * DM) + F.tid) = o; }
        if (BOTH(5)) GRID_BAR();
    }
    if (IN(6)) {
        pg8::Gemm g{F.XN2, F.Wt_up, MT, DFF, DM, DM}; pg8::StaticOrder S; S.init(MT, DFF, F.G, (int)blockIdx.x);
        pg8::EpiRelu2 E{F.HID, DFF, (const float*)(ws + WS_CTL + CTL_SSQ)};
        pg8::gemm_phase<pg8::EpiRelu2, pg8::StaticOrder, true, true>(F.lds + RING_OFF, g, S, E);
        if (F.G == 256) convert_items(F, CV_TAIL2_LO, CV_TAIL2_HI, (int)blockIdx.x - (MT / 256 * (DFF / 256) - 16 * 256), 256 - (MT / 256 * (DFF / 256) - 16 * 256));
        if (BOTH(6)) GRID_BAR();
    }
    if (IN(7)) {
        { pg8::Gemm g{F.HID, F.Wt_dn, MP, DM, DFF, DFF}; pg8::PairOrder S; S.init(MP, DM, F.G, (int)blockIdx.x);
          if (F.G == 256) { pg8::EpiResFinal E{F.out + OUT_Y, F.norm_f, (float*)(ws + WS_CTL + CTL_SSQ2), (unsigned*)(ws + WS_CTL + CTL_PANEL), F.XN2, F.norm2};
              pg8::gemm_phase<pg8::EpiResFinal, pg8::PairOrder, true, true>(F.lds + RING_OFF, g, S, E); }
          else { pg8::EpiRes E{F.out + OUT_Y, F.out + OUT_Y + (size_t)MP * DM, F.out + OUT_Y};
              pg8::gemm_phase<pg8::EpiRes, pg8::PairOrder, true, true>(F.lds + RING_OFF, g, S, E); } }
        { pg8::Gemm g{F.HID, F.Wt_dn, MT, DM, DFF / 8, DFF}; pg8::SplitOrder S; S.init(MP / 256, MS / 256, DM, 8, DFF / 8, F.G, (int)blockIdx.x);
          pg8::EpiPart E{(float*)(ws + WS_PART2), DFF / 8};
          pg8::gemm_phase<pg8::EpiPart, pg8::SplitOrder, true, true>(F.lds + RING_OFF, g, S, E); }
        if (BOTH(7)) GRID_BAR();
    }
    if (IN(8)) {
        const int gw = F.vcu * NWAVES + F.wave, NGW = F.G * NWAVES;
        for (int m = MP + (int)blockIdx.x; m < MT; m += F.G) {
            f32x4 v[2]; float* xrow = F.out + OUT_Y + (size_t)m * DM;
            const float s = sample_row_sum(F, xrow, (const float*)(ws + WS_PART2) + (size_t)(m - MP) * DM, v), r = 1.0f / sqrtf(s * (1.f / DM) + RMS_EPS);
            const GAS f32x4* gp = (const GAS f32x4*)F.norm_f + 2 * F.tid; const f32x4 g0 = gp[0], g1 = gp[1];
            GAS f32x4* xo = (GAS f32x4*)xrow + 2 * F.tid; xo[0] = v[0] * g0 * r; xo[1] = v[1] * g1 * r; }
        if (F.G != 256) for (int m = gw; m < MP; m += NGW) { f32x4 v[16]; float* xrow = F.out + OUT_Y + (size_t)m * DM; row_load_nt(v, xrow, F.lane);
            row_norm_to_f32(v, row_rstd(v), F.norm_f, xrow, F.lane); }
    }
#undef IN
#undef BOTH
}

extern "C" void kernel_launch(void* const* d_in, const int* in_sizes, int n_in, void* d_out, int out_size, void* d_ws, size_t ws_size, hipStream_t stream) {
    static int grid = 0;
    if (grid == 0) {
        if (n_in != 15 || in_sizes[0] != MP * DM || (size_t)out_size != OUT_END || ws_size < WS_END) { fprintf(stderr, "kernel_launch: unexpected shapes (n_in %d, in0 %d, out %d, ws %zu); nothing launched\n", n_in, n_in > 0 ? in_sizes[0] : -1, out_size, ws_size); grid = -1; return; }
        int dev = 0, cus = 0, per_cu = 0;
        if (hipGetDevice(&dev) != hipSuccess || hipDeviceGetAttribute(&cus, hipDeviceAttributeMultiprocessorCount, dev) != hipSuccess) { grid = -1; return; }
        if (hipFuncSetAttribute((const void*)fwd_kernel, hipFuncAttributeMaxDynamicSharedMemorySize, LDS_BYTES) != hipSuccess) { fprintf(stderr, "kernel_launch: hipFuncSetAttribute failed\n"); grid = -1; return; }
        if (hipOccupancyMaxActiveBlocksPerMultiprocessor(&per_cu, (const void*)fwd_kernel, NWAVES * 64, LDS_BYTES) != hipSuccess || per_cu < 1) fprintf(stderr, "kernel_launch: occupancy query reports %d\n", per_cu);
        (void)hipGetLastError();
        grid = cus;
    }
    if (grid < 0) return;
    if (hipMemsetAsync((char*)d_ws + WS_CTL, 0, CTL_ZERO_BYTES, stream) != hipSuccess) return;
    Args a{};
    for (int i = 0; i < 15; ++i) a.in[i] = (const float*)d_in[i];
    a.out = (float*)d_out; a.ws = (unsigned char*)d_ws;
    for (int li = 0; li < N_LAUNCHES; ++li) {
        a.ph_lo = (N_LAUNCHES == NPHASES) ? li : 0; a.ph_hi = (N_LAUNCHES == NPHASES) ? li + 1 : NPHASES; a.li = li; a.pad = 0;
        hipLaunchKernelGGL(fwd_kernel, dim3(grid), dim3(NWAVES * 64), LDS_BYTES, stream, a);
        if (hipPeekAtLastError() != hipSuccess) break;
    }
}
```

```cpp
#include <hip/hip_runtime.h>
#include <cstdio>
#include <cstdint>
constexpr int DM = 4096, MP = 16384, MS = 512, MT = MP + MS, WA = 2048, NIN = 12288, DFF = 16384;
constexpr float RMS_EPS = 1e-6f;

__device__ __forceinline__ float sigm_f(float z) { return __builtin_amdgcn_rcpf(1.0f + __builtin_amdgcn_exp2f(-1.44269504089f * z)); }
__device__ __forceinline__ float gelu_tanh_f(float x) { const float u = x * __builtin_fmaf(x * x, -0.10294324f, -2.30220820f); return x * __builtin_amdgcn_rcpf(1.0f + __builtin_amdgcn_exp2f(u)); }
__device__ __forceinline__ float silu_f(float x) { return x * sigm_f(x); }
typedef _Float16 h16x2 __attribute__((ext_vector_type(2)));
__device__ __forceinline__ unsigned pk_f16(float lo, float hi) { h16x2 h; h.x = (_Float16)lo; h.y = (_Float16)hi; return __builtin_bit_cast(unsigned, h); }

namespace pg8 {
#define PG8_LAS __attribute__((address_space(3)))
typedef unsigned short bf16_t;
typedef short bf16x8 __attribute__((ext_vector_type(8)));
typedef float f32x4 __attribute__((ext_vector_type(4)));
typedef unsigned u32x4 __attribute__((ext_vector_type(4)));
constexpr int BM = 256, BK = 64, HALF = 128, HTB = HALF * BK * 2  , STAGE_BYTES = 8 * HTB, NXCD = 8, WGM = 8;

__host__ __device__ __forceinline__ int lds_byte(int r, int c) { const int st = (r >> 4) * 2 + (c >> 5), rr = r & 15, cc = c & 31, ob = rr * 64 + cc * 2; return st * 1024 + (ob ^ (((ob >> 9) & 1) << 5)); }
__host__ __device__ __forceinline__ void stage_rc(int b, int& R, int& C) { const int st = b / 1024, sb = b % 1024, swz = sb ^ (((sb >> 9) & 1) << 5); R = (st >> 1) * 16 + swz / 64; C = (st & 1) * 32 + (swz % 64) / 2; }
__host__ __device__ __forceinline__ int perm32(int rho) { const int n = rho >> 4, i = rho & 15; return 8 * (i >> 2) + 4 * n + (i & 3); }

struct Unit { int pm, pn, k0; };
struct Gemm { const bf16_t* A; const bf16_t* Bt; int M, N, K, lda; };

struct StaticOrder {
    int nM, nN, nwg, G, c, wgm;
    __host__ __device__ void init(int M, int N, int G_, int c_, int wgm_ = WGM) { nM = M / BM; nN = N / BM; nwg = nM * nN; G = G_; c = c_; wgm = wgm_; }
    __host__ __device__ bool next(int i, Unit& u) const {
        const long L = (long)i * G + c; if (L >= nwg) return false;
        int wgid = (int)L; { const int q = nwg / NXCD, r = nwg % NXCD, xcd = wgid % NXCD, off = wgid / NXCD; wgid = (xcd < r ? xcd * (q + 1) : r * (q + 1) + (xcd - r) * q) + off; }
        const int nig = wgm * nN, gid = wgid / nig, fm = gid * wgm, gsz = (nM - fm) < wgm ? (nM - fm) : wgm;
        u.pm = fm + ((wgid % nig) % gsz); u.pn = (wgid % nig) / gsz; u.k0 = 0; return true;
    }
    __device__ __forceinline__ void a_ready(const Unit&) const {}
    __device__ __forceinline__ void done(const Unit&) const {}
};
__device__ __forceinline__ unsigned cvt_pk_bf16(float lo, float hi) { unsigned r; asm volatile("v_cvt_pk_bf16_f32 %0, %1, %2" : "=v"(r) : "v"(lo), "v"(hi)); return r; }
typedef float f32x2 __attribute__((ext_vector_type(2)));
struct EpiProj {
    static constexpr bool PERM = true, AFTER_DRAIN = false;
    bf16_t* P; const float* lbl;
    template <int ACT> __device__ __forceinline__ void run(const f32x4 (&acc)[2][2][4][2], bf16_t* base, int row0, int col0) const {
        f32x4 lb[2][2];
#pragma unroll
        for (int bj = 0; bj < 2; ++bj)
#pragma unroll
            for (int n = 0; n < 2; ++n) {
                if (ACT == 2) { const f32x4 a = *(const f32x4*)(lbl + col0 + bj * HALF + 4 * n), b = *(const f32x4*)(lbl + 2048 + col0 + bj * HALF + 4 * n);
#pragma unroll
                    for (int e = 0; e < 4; ++e) lb[bj][n][e] = sigm_f(a[e] - b[e]); }
                else lb[bj][n] = (f32x4){0.f, 0.f, 0.f, 0.f}; }
#pragma unroll
        for (int ai = 0; ai < 2; ++ai)
#pragma unroll
            for (int m = 0; m < 4; ++m) { bf16_t* rowp = base + (size_t)(row0 + ai * HALF + m * 16) * 2048 + col0;
#pragma unroll
                for (int bj = 0; bj < 2; ++bj) { f32x4 v0 = acc[ai][bj][m][0], v1 = acc[ai][bj][m][1]; u32x4 w;
#pragma unroll
                    for (int e = 0; e < 4; ++e) {
                        if (ACT == 0) { v0[e] = gelu_tanh_f(v0[e]); v1[e] = gelu_tanh_f(v1[e]); }
                        if (ACT == 1) { v0[e] = silu_f(v0[e]); v1[e] = silu_f(v1[e]); }
                        if (ACT == 2) { const float l0 = lb[bj][0][e], l1 = lb[bj][1][e];
                            v0[e] = l0 + (1.0f - l0) * sigm_f(v0[e]); v1[e] = l1 + (1.0f - l1) * sigm_f(v1[e]); } }
                    if (ACT == 2) { w.x = pk_f16(v0[0], v0[1]); w.y = pk_f16(v0[2], v0[3]); w.z = pk_f16(v1[0], v1[1]); w.w = pk_f16(v1[2], v1[3]); }
                    else { w.x = cvt_pk_bf16(v0[0], v0[1]); w.y = cvt_pk_bf16(v0[2], v0[3]); w.z = cvt_pk_bf16(v1[0], v1[1]); w.w = cvt_pk_bf16(v1[2], v1[3]); }
                    *(u32x4*)(rowp + bj * HALF) = w; } }
    }
    __device__ __forceinline__ void operator()(const f32x4 (&acc)[2][2][4][2], const Unit& u, int wr, int wc, int fr, int fq) const {
        const int region = u.pn >> 3, row0 = u.pm * BM + wr * 64 + fr, col0 = (u.pn & 7) * BM + wc * 32 + 8 * fq;
        bf16_t* base = P + (size_t)region * ((size_t)MT * 2048);
        if (region <= 1) run<0>(acc, base, row0, col0);
        else if (region == 2 || region == 5) run<1>(acc, base, row0, col0);
        else if (region == 3) run<2>(acc, base, row0, col0);
        else run<3>(acc, base, row0, col0);
    }
};
__device__ __forceinline__ void epi_load_batch(const float* base, size_t off0, f32x4 (&b)[2][4]) {
#pragma unroll
    for (int r = 0; r < 2; ++r)
#pragma unroll
        for (int bj = 0; bj < 2; ++bj)
#pragma unroll
            for (int n = 0; n < 2; ++n) b[r][bj * 2 + n] = __builtin_nontemporal_load((const f32x4*)(base + off0 + (size_t)r * 16 * DM + bj * HALF + n * 16));
}
struct EpiRes {
    static constexpr bool PERM = false, AFTER_DRAIN = false;
    const float* bp; const float* bs; float* out;
    __device__ __forceinline__ void store_batch(const f32x4 (&acc)[2][2][4][2], int batch, size_t off0, const f32x4 (&b)[2][4]) const {
        const int ai = batch >> 1, m0 = (batch & 1) * 2;
#pragma unroll
        for (int r = 0; r < 2; ++r)
#pragma unroll
            for (int bj = 0; bj < 2; ++bj)
#pragma unroll
                for (int n = 0; n < 2; ++n) *(f32x4*)(out + off0 + (size_t)r * 16 * DM + bj * HALF + n * 16) = acc[ai][bj][m0 + r][n] + b[r][bj * 2 + n];
    }
    __device__ __forceinline__ void operator()(const f32x4 (&acc)[2][2][4][2], const Unit& u, int wr, int wc, int fr, int fq) const {
        const int row0 = u.pm * BM + wr * 64 + fr, col0 = u.pn * BM + wc * 32 + 4 * fq;
        const float* base = (u.pm < MP / BM) ? bp : bs - (size_t)MP * DM;
        size_t off[4];
#pragma unroll
        for (int t = 0; t < 4; ++t) off[t] = (size_t)(row0 + (t >> 1) * HALF + (t & 1) * 32) * DM + col0;
        f32x4 b0[2][4], b1[2][4];
        epi_load_batch(base, off[0], b0); epi_load_batch(base, off[1], b1);
        asm volatile("" ::: "memory");
        store_batch(acc, 0, off[0], b0); epi_load_batch(base, off[2], b0);
        asm volatile("" ::: "memory");
        store_batch(acc, 1, off[1], b1); epi_load_batch(base, off[3], b1);
        asm volatile("" ::: "memory");
        store_batch(acc, 2, off[2], b0);
        store_batch(acc, 3, off[3], b1);
    }
};
struct EpiResNorm {
    static constexpr bool PERM = false, AFTER_DRAIN = false;
    const float* bp; float* out; bf16_t* xg; const float* g; float* ssq; bool store_x1;
    __device__ __forceinline__ void store_batch(const f32x4 (&acc)[2][2][4][2], int batch, size_t off0, int rowb, const f32x4 (&b)[2][4], const f32x4 (&gv)[2][2], int fq) const {
        typedef unsigned u32x2 __attribute__((ext_vector_type(2)));
        const int ai = batch >> 1, m0 = (batch & 1) * 2;
#pragma unroll
        for (int r = 0; r < 2; ++r) { float sq = 0.f;
#pragma unroll
            for (int bj = 0; bj < 2; ++bj)
#pragma unroll
                for (int n = 0; n < 2; ++n) { const f32x4 x = acc[ai][bj][m0 + r][n] + b[r][bj * 2 + n]; const size_t o = off0 + (size_t)r * 16 * DM + bj * HALF + n * 16; if (store_x1) *(f32x4*)(out + o) = x;
                    sq += (x[0] * x[0] + x[1] * x[1]) + (x[2] * x[2] + x[3] * x[3]); const f32x4 y = x * gv[bj][n];
                    u32x2 w; w.x = cvt_pk_bf16(y[0], y[1]); w.y = cvt_pk_bf16(y[2], y[3]); *(u32x2*)(xg + o) = w; }
            sq += __shfl_xor(sq, 16); sq += __shfl_xor(sq, 32);
            if (fq == 0) atomicAdd(ssq + rowb + r * 16, sq); }
    }
    __device__ __forceinline__ void operator()(const f32x4 (&acc)[2][2][4][2], const Unit& u, int wr, int wc, int fr, int fq) const {
        const int row0 = u.pm * BM + wr * 64 + fr, col0 = u.pn * BM + wc * 32 + 4 * fq;
        f32x4 gv[2][2];
#pragma unroll
        for (int bj = 0; bj < 2; ++bj)
#pragma unroll
            for (int n = 0; n < 2; ++n) gv[bj][n] = *(const f32x4*)(g + col0 + bj * HALF + n * 16);
        size_t off[4]; int rowb[4];
#pragma unroll
        for (int t = 0; t < 4; ++t) { rowb[t] = row0 + (t >> 1) * HALF + (t & 1) * 32; off[t] = (size_t)rowb[t] * DM + col0; }
        f32x4 b0[2][4], b1[2][4];
        epi_load_batch(bp, off[0], b0); epi_load_batch(bp, off[1], b1);
        asm volatile("" ::: "memory");
        store_batch(acc, 0, off[0], rowb[0], b0, gv, fq); epi_load_batch(bp, off[2], b0);
        asm volatile("" ::: "memory");
        store_batch(acc, 1, off[1], rowb[1], b1, gv, fq); epi_load_batch(bp, off[3], b1);
        asm volatile("" ::: "memory");
        store_batch(acc, 2, off[2], rowb[2], b0, gv, fq);
        store_batch(acc, 3, off[3], rowb[3], b1, gv, fq);
    }
};
struct PairOrder {
    StaticOrder so; bool paired;
    __host__ __device__ void init(int M, int N, int G_, int c_) { so.init(M, N, G_, c_, 4); paired = (G_ == 256 && M / BM == 64 && N / BM == 16); }
    __host__ __device__ bool next(int i, Unit& u) const {
        if (!paired) return so.next(i, u);
        if (i >= 4) return false;
        const int xcd = so.c & 7, j = so.c >> 3;
        u.pm = 4 * ((xcd >> 1) + 4 * i) + (j & 3); u.pn = 8 * (xcd & 1) + (j >> 2); u.k0 = 0; return true;
    }
    __device__ __forceinline__ void a_ready(const Unit&) const {}
    __device__ __forceinline__ void done(const Unit&) const {}
};
struct EpiResFinal {
    static constexpr bool PERM = false, AFTER_DRAIN = false;
    float* out; const float* g; float* ssq2; unsigned* cnt; const bf16_t* xg; const float* g2;
    __device__ __forceinline__ void add_batch(f32x4 (&acc)[2][2][4][2], int batch, int rowb, const f32x4 (&b)[2][4], int fq) const {
        const int ai = batch >> 1, m0 = (batch & 1) * 2;
#pragma unroll
        for (int r = 0; r < 2; ++r) { float sq = 0.f;
#pragma unroll
            for (int bj = 0; bj < 2; ++bj)
#pragma unroll
                for (int n = 0; n < 2; ++n) { const f32x4 x = acc[ai][bj][m0 + r][n] + b[r][bj * 2 + n]; acc[ai][bj][m0 + r][n] = x; sq += (x[0] * x[0] + x[1] * x[1]) + (x[2] * x[2] + x[3] * x[3]); }
            sq += __shfl_xor(sq, 16); sq += __shfl_xor(sq, 32);
            if (fq == 0) atomicAdd(ssq2 + rowb + r * 16, sq); }
    }
    __device__ __forceinline__ void load_x1(size_t off0, f32x4 (&b)[2][4], const f32x4 (&ig)[2][2]) const {
        typedef unsigned u32x2 __attribute__((ext_vector_type(2)));
#pragma unroll
        for (int r = 0; r < 2; ++r)
#pragma unroll
            for (int bj = 0; bj < 2; ++bj)
#pragma unroll
                for (int n = 0; n < 2; ++n) { const u32x2 w = __builtin_nontemporal_load((const u32x2*)(xg + off0 + (size_t)r * 16 * DM + bj * HALF + n * 16));
                    b[r][bj * 2 + n] = (f32x4){__builtin_bit_cast(float, w.x << 16), __builtin_bit_cast(float, w.x & 0xffff0000u), __builtin_bit_cast(float, w.y << 16), __builtin_bit_cast(float, w.y & 0xffff0000u)} * ig[bj][n]; }
    }
    __device__ __forceinline__ void operator()(const f32x4 (&acc_c)[2][2][4][2], const Unit& u, int wr, int wc, int fr, int fq) const {
        f32x4 (&acc)[2][2][4][2] = const_cast<f32x4 (&)[2][2][4][2]>(acc_c);
        const int row0 = u.pm * BM + wr * 64 + fr, col0 = u.pn * BM + wc * 32 + 4 * fq;
        size_t off[4]; int rowb[4];
#pragma unroll
        for (int t = 0; t < 4; ++t) { rowb[t] = row0 + (t >> 1) * HALF + (t & 1) * 32; off[t] = (size_t)rowb[t] * DM + col0; }
        f32x4 ig[2][2];
#pragma unroll
        for (int bj = 0; bj < 2; ++bj)
#pragma unroll
            for (int n = 0; n < 2; ++n) { const f32x4 gg = *(const f32x4*)(g2 + col0 + bj * HALF + n * 16); ig[bj][n] = (f32x4){__builtin_amdgcn_rcpf(gg[0]), __builtin_amdgcn_rcpf(gg[1]), __builtin_amdgcn_rcpf(gg[2]), __builtin_amdgcn_rcpf(gg[3])}; }
        f32x4 b0[2][4], b1[2][4];
        load_x1(off[0], b0, ig); load_x1(off[1], b1, ig);
        asm volatile("" ::: "memory");
        add_batch(acc, 0, rowb[0], b0, fq); load_x1(off[2], b0, ig);
        asm volatile("" ::: "memory");
        add_batch(acc, 1, rowb[1], b1, fq); load_x1(off[3], b1, ig);
        asm volatile("" ::: "memory");
        add_batch(acc, 2, rowb[2], b0, fq);
        add_batch(acc, 3, rowb[3], b1, fq);
        asm volatile("s_waitcnt vmcnt(0)" ::: "memory");
        unsigned* pc = cnt + 64 * u.pm;
        if (fr == 0 && fq == 0) __hip_atomic_fetch_add(pc, 1u, __ATOMIC_RELAXED, __HIP_MEMORY_SCOPE_AGENT);
        for (unsigned spins = 0; (unsigned)__builtin_amdgcn_readfirstlane((int)__hip_atomic_load(pc, __ATOMIC_RELAXED, __HIP_MEMORY_SCOPE_AGENT)) < 128u; ) { __builtin_amdgcn_s_sleep(2); if (++spins > (1u << 17)) break; }
        f32x4 gv[2][2];
#pragma unroll
        for (int bj = 0; bj < 2; ++bj)
#pragma unroll
            for (int n = 0; n < 2; ++n) gv[bj][n] = *(const f32x4*)(g + col0 + bj * HALF + n * 16);
        unsigned sqb[4][2];
#pragma unroll
        for (int t = 0; t < 4; ++t)
#pragma unroll
            for (int r = 0; r < 2; ++r) sqb[t][r] = __hip_atomic_load((unsigned*)(ssq2 + rowb[t] + r * 16), __ATOMIC_RELAXED, __HIP_MEMORY_SCOPE_AGENT);
        asm volatile("" ::: "memory");
#pragma unroll
        for (int t = 0; t < 4; ++t) { const int ai = t >> 1, m0 = (t & 1) * 2;
#pragma unroll
            for (int r = 0; r < 2; ++r) { const float sq = __builtin_bit_cast(float, sqb[t][r]);
                const float rs = __builtin_amdgcn_rsqf(sq * (1.f / DM) + RMS_EPS);
#pragma unroll
                for (int bj = 0; bj < 2; ++bj)
#pragma unroll
                    for (int n = 0; n < 2; ++n) __builtin_nontemporal_store(acc[ai][bj][m0 + r][n] * gv[bj][n] * rs, (f32x4*)(out + off[t] + (size_t)r * 16 * DM + bj * HALF + n * 16)); } }
    }
};
struct SplitOrder {
    int nN, nsplit, kext, pm0, ntot, G, c;
    __host__ __device__ void init(int pm0_, int nMs, int N, int nsplit_, int kext_, int G_, int c_) { nN = N / BM; nsplit = nsplit_; kext = kext_; pm0 = pm0_; ntot = nMs * nN * nsplit; G = G_; c = c_; }
    __host__ __device__ bool next(int i, Unit& u) const { const int j = i * G + c; if (j >= ntot) return false; const int ks = j % nsplit, r = j / nsplit; u.pn = r % nN; u.pm = pm0 + r / nN; u.k0 = ks * kext; return true; }
    __device__ __forceinline__ void a_ready(const Unit&) const {}
    __device__ __forceinline__ void done(const Unit&) const {}
};
struct EpiPart {
    static constexpr bool PERM = false, AFTER_DRAIN = false;
    float* part; int kext;
    __device__ __forceinline__ void operator()(const f32x4 (&acc)[2][2][4][2], const Unit& u, int wr, int wc, int fr, int fq) const {
        const int row0 = u.pm * BM - MP + wr * 64 + fr, col0 = u.pn * BM + wc * 32 + 4 * fq;
        float* base = part + (size_t)(u.k0 / kext) * ((size_t)MS * DM);
#pragma unroll
        for (int ai = 0; ai < 2; ++ai)
#pragma unroll
            for (int m = 0; m < 4; ++m) { const size_t off = (size_t)(row0 + ai * HALF + m * 16) * DM + col0;
#pragma unroll
                for (int bj = 0; bj < 2; ++bj)
#pragma unroll
                    for (int n = 0; n < 2; ++n) *(f32x4*)(base + off + bj * HALF + n * 16) = acc[ai][bj][m][n]; }
    }
};
struct EpiRelu2 {
    static constexpr bool PERM = true, AFTER_DRAIN = false;
    bf16_t* O; int ldc; const float* ssq;
    __device__ __forceinline__ void operator()(const f32x4 (&acc)[2][2][4][2], const Unit& u, int wr, int wc, int fr, int fq) const {
        const int row0 = u.pm * BM + wr * 64 + fr, col0 = u.pn * BM + wc * 32 + 8 * fq;
        float r2[2][4];
#pragma unroll
        for (int ai = 0; ai < 2; ++ai)
#pragma unroll
            for (int m = 0; m < 4; ++m) r2[ai][m] = __builtin_amdgcn_rcpf(ssq[row0 + ai * HALF + m * 16] * (1.f / DM) + RMS_EPS);
#pragma unroll
        for (int ai = 0; ai < 2; ++ai)
#pragma unroll
            for (int m = 0; m < 4; ++m) { bf16_t* rowp = O + (size_t)(row0 + ai * HALF + m * 16) * ldc + col0;
#pragma unroll
                for (int bj = 0; bj < 2; ++bj) { f32x4 v0 = acc[ai][bj][m][0], v1 = acc[ai][bj][m][1];
#pragma unroll
                    for (int e = 0; e < 4; ++e) { const float a = fmaxf(v0[e], 0.f), b = fmaxf(v1[e], 0.f); v0[e] = a * a * r2[ai][m]; v1[e] = b * b * r2[ai][m]; }
                    u32x4 w; w.x = cvt_pk_bf16(v0[0], v0[1]); w.y = cvt_pk_bf16(v0[2], v0[3]); w.z = cvt_pk_bf16(v1[0], v1[1]); w.w = cvt_pk_bf16(v1[2], v1[3]);
                    *(u32x4*)(rowp + bj * HALF) = w; } }
    }
};
template <class Epi, class Sched, bool ALIGN_EPI = false, bool SP2 = false>
__device__ __forceinline__ void gemm_phase(PG8_LAS unsigned char* lds, const Gemm g, const Sched& S, const Epi& E) {
    const int tid = threadIdx.x, wid = __builtin_amdgcn_readfirstlane(tid >> 6), lane = tid & 63, wr = wid >> 2, wc = wid & 3, fr = lane & 15, fq = lane >> 4;
    const int K = g.lda, nt = g.K / BK;
    unsigned voffA[2], voffB[2];
#pragma unroll
    for (int i = 0; i < 2; ++i) { int R, C; stage_rc(tid * 16 + i * 8192, R, C); const int Rb = Epi::PERM ? ((R & ~31) + perm32(R & 31)) : R;
        voffA[i] = (unsigned)(R * K + C) * 2u; voffB[i] = (unsigned)(Rb * K + C) * 2u; }
    const size_t kstep = (size_t)(BK * 2);
    const size_t hstep = (size_t)HALF * K * 2;
    const size_t tstep = 2 * hstep;
    const unsigned ldsw = (unsigned)wid * 1024u;
    const int aoff = lds_byte(wr * 64 + fr, fq * 8), boff = lds_byte(wc * 32 + fr, fq * 8);
#define PG8_SA(b, h) (((b) * 2 + (h)) * HTB)
#define PG8_SB(b, h) ((4 + (b) * 2 + (h)) * HTB)
#define PG8_STAGE(bufoff, gbase, voff) do { _Pragma("unroll") for (int _i = 0; _i < 2; ++_i) \
        __builtin_amdgcn_global_load_lds((const unsigned*)((const char*)(gbase) + (voff)[_i]), (PG8_LAS unsigned*)(lds + (bufoff) + ldsw + _i * 8192), 16, 0, 0); } while (0)
#define PG8_LDA(dst, b, h) do { _Pragma("unroll") for (int m = 0; m < 4; ++m) _Pragma("unroll") for (int k = 0; k < 2; ++k) dst[m][k] = *(const PG8_LAS bf16x8*)(lds + PG8_SA(b, h) + aoff + m * 2048 + k * 1024); } while (0)
#define PG8_LDB(dst, b, h) do { _Pragma("unroll") for (int n = 0; n < 2; ++n) _Pragma("unroll") for (int k = 0; k < 2; ++k) dst[n][k] = *(const PG8_LAS bf16x8*)(lds + PG8_SB(b, h) + boff + n * 2048 + k * 1024); } while (0)
#define PG8_MMA(ai, bj, At, Bt) do { __builtin_amdgcn_s_setprio(1); _Pragma("unroll") for (int m = 0; m < 4; ++m) _Pragma("unroll") for (int n = 0; n < 2; ++n) _Pragma("unroll") for (int k = 0; k < 2; ++k) \
        acc[ai][bj][m][n] = __builtin_amdgcn_mfma_f32_16x16x32_bf16(Bt[n][k], At[m][k], acc[ai][bj][m][n], 0, 0, 0); __builtin_amdgcn_s_setprio(0); } while (0)
#define PG8_WAIT_V(n) asm volatile("s_waitcnt vmcnt(" #n ")" ::: "memory")
#define PG8_WAIT_L(n) asm volatile("s_waitcnt lgkmcnt(" #n ")" ::: "memory")
#define PG8_BAR __builtin_amdgcn_s_barrier()
#define PG8_SCHED __builtin_amdgcn_sched_barrier(0)
    Unit cur, nxt; int ui = 0;
    if (!S.next(0, cur)) return;
    f32x4 acc[2][2][4][2];
#pragma unroll
    for (int a = 0; a < 2; ++a)
#pragma unroll
        for (int b = 0; b < 2; ++b)
#pragma unroll
            for (int m = 0; m < 4; ++m)
#pragma unroll
                for (int n = 0; n < 2; ++n) acc[a][b][m][n] = (f32x4){0.f, 0.f, 0.f, 0.f};
    bf16x8 At[4][2], B0[2][2], B1[2][2];
    const char* cA = (const char*)g.A + (size_t)cur.pm * tstep + (size_t)cur.k0 * 2; const char* cB = (const char*)g.Bt + (size_t)cur.pn * tstep + (size_t)cur.k0 * 2;
    S.a_ready(cur);
    if constexpr (SP2) {
        PG8_STAGE(PG8_SB(0, 0), cB, voffB); PG8_STAGE(PG8_SB(0, 1), cB + hstep, voffB); PG8_STAGE(PG8_SA(0, 0), cA, voffA); PG8_STAGE(PG8_SA(0, 1), cA + hstep, voffA);
        if (wr == 1) PG8_BAR;
        PG8_WAIT_V(2); PG8_BAR;
        PG8_STAGE(PG8_SB(1, 0), cB + kstep, voffB); PG8_STAGE(PG8_SA(1, 0), cA + kstep, voffA); PG8_STAGE(PG8_SB(1, 1), cB + hstep + kstep, voffB);
        PG8_WAIT_V(6); PG8_BAR;
    } else {
        PG8_STAGE(PG8_SB(0, 0), cB, voffB); PG8_STAGE(PG8_SA(0, 0), cA, voffA); PG8_STAGE(PG8_SB(0, 1), cB + hstep, voffB); PG8_STAGE(PG8_SA(0, 1), cA + hstep, voffA);
        if (wr == 1) PG8_BAR;
        PG8_WAIT_V(4); PG8_BAR;
        PG8_STAGE(PG8_SB(1, 0), cB + kstep, voffB); PG8_STAGE(PG8_SA(1, 0), cA + kstep, voffA); PG8_STAGE(PG8_SB(1, 1), cB + hstep + kstep, voffB);
        PG8_WAIT_V(6); PG8_BAR;
    }
    for (;;) {
        const bool has_next = S.next(ui + 1, nxt);
        const char* nA = has_next ? (const char*)g.A + (size_t)nxt.pm * tstep + (size_t)nxt.k0 * 2 : cA; const char* nB = has_next ? (const char*)g.Bt + (size_t)nxt.pn * tstep + (size_t)nxt.k0 * 2 : cB;
        for (int t = 0; t < nt; t += 2) {
            const bool last = (t == nt - 2);
            const char* a1 = cA + (size_t)(t + 1) * kstep;
            const char* a2 = last ? nA : cA + (size_t)(t + 2) * kstep; const char* b2 = last ? nB : cB + (size_t)(t + 2) * kstep;
            const char* a3 = a2 + kstep; const char* b3 = b2 + kstep;
            if (last && has_next) S.a_ready(nxt);
            if constexpr (SP2) {
            PG8_LDB(B0, 0, 0); PG8_LDB(B1, 0, 1); PG8_SCHED; PG8_LDA(At, 0, 0); PG8_STAGE(PG8_SA(1, 1), a1 + hstep, voffA);
            PG8_WAIT_V(8); PG8_WAIT_L(0); PG8_BAR; PG8_MMA(0, 0, At, B0); PG8_MMA(0, 1, At, B1); PG8_BAR; PG8_SCHED;
            PG8_LDA(At, 0, 1); PG8_STAGE(PG8_SB(0, 0), b2, voffB); PG8_STAGE(PG8_SB(0, 1), b2 + hstep, voffB); PG8_STAGE(PG8_SA(0, 0), a2, voffA);
            PG8_WAIT_V(8); PG8_WAIT_L(0); PG8_BAR; PG8_MMA(1, 0, At, B0); PG8_MMA(1, 1, At, B1); PG8_BAR; PG8_SCHED;
            PG8_LDB(B0, 1, 0); PG8_LDB(B1, 1, 1); PG8_SCHED; PG8_LDA(At, 1, 0); PG8_STAGE(PG8_SA(0, 1), a2 + hstep, voffA);
            PG8_WAIT_V(8); PG8_WAIT_L(0); PG8_BAR; PG8_MMA(0, 0, At, B0); PG8_MMA(0, 1, At, B1); PG8_BAR; PG8_SCHED;
            PG8_LDA(At, 1, 1); PG8_STAGE(PG8_SB(1, 0), b3, voffB); PG8_STAGE(PG8_SB(1, 1), b3 + hstep, voffB); PG8_STAGE(PG8_SA(1, 0), a3, voffA);
            PG8_WAIT_V(8); PG8_WAIT_L(0); PG8_BAR; PG8_MMA(1, 0, At, B0); PG8_MMA(1, 1, At, B1); PG8_BAR; PG8_SCHED;
            } else {
            PG8_LDB(B0, 0, 0); PG8_SCHED; PG8_LDA(At, 0, 0); PG8_STAGE(PG8_SA(1, 1), a1 + hstep, voffA);
            PG8_WAIT_L(8); PG8_BAR; PG8_WAIT_L(0); PG8_MMA(0, 0, At, B0); PG8_BAR; PG8_SCHED;
            PG8_LDB(B1, 0, 1); PG8_STAGE(PG8_SB(0, 0), b2, voffB);
            PG8_BAR; PG8_WAIT_L(0); PG8_MMA(0, 1, At, B1); PG8_BAR;
            PG8_LDA(At, 0, 1); PG8_STAGE(PG8_SA(0, 0), a2, voffA);
            PG8_BAR; PG8_WAIT_L(0); PG8_MMA(1, 0, At, B0); PG8_BAR; PG8_SCHED;
            PG8_STAGE(PG8_SB(0, 1), b2 + hstep, voffB);
            PG8_WAIT_V(6); PG8_BAR; PG8_MMA(1, 1, At, B1); PG8_BAR;
            PG8_LDB(B0, 1, 0); PG8_SCHED; PG8_LDA(At, 1, 0); PG8_STAGE(PG8_SA(0, 1), a2 + hstep, voffA);
            PG8_WAIT_L(8); PG8_BAR; PG8_WAIT_L(0); PG8_MMA(0, 0, At, B0); PG8_BAR; PG8_SCHED;
            PG8_LDB(B1, 1, 1); PG8_STAGE(PG8_SB(1, 0), b3, voffB);
            PG8_BAR; PG8_WAIT_L(0); PG8_MMA(0, 1, At, B1); PG8_BAR;
            PG8_LDA(At, 1, 1); PG8_STAGE(PG8_SA(1, 0), a3, voffA);
            PG8_BAR; PG8_WAIT_L(0); PG8_MMA(1, 0, At, B0); PG8_BAR; PG8_SCHED;
            PG8_STAGE(PG8_SB(1, 1), b3 + hstep, voffB);
            PG8_WAIT_V(6); PG8_BAR; PG8_MMA(1, 1, At, B1); PG8_BAR;
            }
        }
        if constexpr (ALIGN_EPI) { if (wr == 0) PG8_BAR; }
        if constexpr (!Epi::AFTER_DRAIN) { E(acc, cur, wr, wc, fr, fq); S.done(cur); }
        if (!has_next) break;
#pragma unroll
        for (int a = 0; a < 2; ++a)
#pragma unroll
            for (int b = 0; b < 2; ++b)
#pragma unroll
                for (int m = 0; m < 4; ++m)
#pragma unroll
                    for (int n = 0; n < 2; ++n) acc[a][b][m][n] = (f32x4){0.f, 0.f, 0.f, 0.f};
        cur = nxt; cA = nA; cB = nB; ++ui;
        if constexpr (ALIGN_EPI) { if (wr == 1) PG8_BAR; }
    }
    PG8_WAIT_V(0);
    if constexpr (!ALIGN_EPI) { if (wr == 0) PG8_BAR; }
    PG8_BAR;
    if constexpr (Epi::AFTER_DRAIN) { E.fused(acc, cur, wr, wc, fr, fq, lds, wid, lane); S.done(cur); }
#undef PG8_SA
#undef PG8_SB
#undef PG8_STAGE
#undef PG8_LDA
#undef PG8_LDB
#undef PG8_MMA
#undef PG8_WAIT_V
#undef PG8_WAIT_L
#undef PG8_BAR
#undef PG8_SCHED
}
}
#define GAS __attribute__((address_space(1)))
#define LAS __attribute__((address_space(3)))
typedef unsigned short bf16;
typedef float f32x4 __attribute__((ext_vector_type(4)));
typedef float f32x2 __attribute__((ext_vector_type(2)));
typedef unsigned v4u __attribute__((ext_vector_type(4)));
typedef unsigned v2u __attribute__((ext_vector_type(2)));
typedef GAS unsigned gu32;
#define RLX_AGENT __ATOMIC_RELAXED, __HIP_MEMORY_SCOPE_AGENT
#define LDS_WAIT() asm volatile("s_waitcnt lgkmcnt(0)" ::: "memory")
#define VM_WAIT() asm volatile("s_waitcnt vmcnt(0)" ::: "memory")
#define LBAR() do { asm volatile("s_waitcnt lgkmcnt(0)" ::: "memory"); __builtin_amdgcn_s_barrier(); asm volatile("" ::: "memory"); } while (0)
#define SCHED_FENCE() __builtin_amdgcn_sched_barrier(0)
constexpr int NWAVES = 8;
constexpr int NHEAVY = 128, HSPLIT = 39;
#ifndef MK_N_LAUNCHES
#define MK_N_LAUNCHES 1
#endif
constexpr int NPHASES = 9;
constexpr int N_LAUNCHES = MK_N_LAUNCHES;

constexpr size_t MiB = 1u << 20;
constexpr size_t WS_CTL = 0, CTL_ZERO_BYTES = 1 * MiB;
constexpr size_t WS_WUP = 2 * MiB, WS_WDN = 130 * MiB;
constexpr size_t WS_XN2 = 258 * MiB;
constexpr size_t WS_P = 390 * MiB, P_STRIDE = (size_t)MT * 2048 * 2;
constexpr size_t WS_XN = WS_P + 6 * P_STRIDE;
constexpr size_t WS_HID = WS_P;
constexpr size_t WS_WIN = WS_HID + (size_t)MT * DFF * 2, WS_WOUT = WS_WIN + (size_t)NIN * DM * 2;
constexpr size_t WS_END = WS_WOUT + (size_t)DM * DM * 2;
constexpr size_t WS_PART1 = WS_P, WS_PART2 = WS_WUP;
constexpr size_t CTL_SSQ2 = 384 * 1024, CTL_PANEL = 512 * 1024;
constexpr size_t CTL_SSQ = 256 * 1024;
static_assert(WS_WUP + (size_t)DFF * DM * 2 <= WS_WDN && WS_WDN + (size_t)DM * DFF * 2 <= WS_XN2 && WS_XN2 + (size_t)MT * DM * 2 <= WS_P, "ws map: weights / XN2");
static_assert(WS_XN + (size_t)MT * DM * 2 <= WS_WIN && WS_XN + (size_t)MT * DM * 2 == WS_HID + (size_t)MT * DFF * 2 && CTL_SSQ + (size_t)MT * 4 <= CTL_ZERO_BYTES, "ws map: activations");
constexpr int CW_BAR = 4096;
constexpr size_t OUT_Y = 0, OUT_SP = (size_t)MT * DM, OUT_SS = OUT_SP + (size_t)4 * 16 * 128 * 128, OUT_VS = OUT_SS + (size_t)32 * 16 * 128 * 128, OUT_END = OUT_VS + (size_t)32 * 16 * 2048;
constexpr int RING_OFF = 0, RING_BYTES = 131072;
constexpr int LDS_BYTES = 163840;
constexpr int LDSCTL_OFF = LDS_BYTES - 1024, MISC_OFF = LDSCTL_OFF + 320;

__device__ __forceinline__ unsigned f2bf(float f) { unsigned u = __builtin_bit_cast(unsigned, f); return (u + 0x7fffu + ((u >> 16) & 1u)) >> 16; }
__device__ __forceinline__ unsigned pk2(float lo, float hi) { return f2bf(lo) | (f2bf(hi) << 16); }
__device__ __forceinline__ float bf2f(unsigned b) { return __builtin_bit_cast(float, b << 16); }
__device__ __forceinline__ float h2f(unsigned h) { return (float)__builtin_bit_cast(_Float16, (unsigned short)h); }
#define XB_TMO      128
#define XB_XCNT(j)  (256  + 64 * (j))
#define XB_XSUB(j)  (1280 + 64 * (j))
#define XB_XGEN(j)  (2304 + 64 * (j))
#define XB_TOP      3328
#define XB_TOPGEN   3392
#define XCD_BAR_WORDS 3456
#define XB_SPIN_CAP (1u << 18)

__device__ __forceinline__ unsigned xb_ld(unsigned* p)              { return __hip_atomic_load(p, __ATOMIC_RELAXED, __HIP_MEMORY_SCOPE_AGENT); }
__device__ __forceinline__ unsigned xb_add(unsigned* p, unsigned v) { return __hip_atomic_fetch_add(p, v, __ATOMIC_RELAXED, __HIP_MEMORY_SCOPE_AGENT); }
__device__ __forceinline__ unsigned xb_xcc_id() { return (unsigned)__builtin_amdgcn_s_getreg((3 << 11) | 20) & 0xFu; }
#define XB_SPIN(cond, bar) do { unsigned _sp = 0; while (cond) { __builtin_amdgcn_s_sleep(1); \
    if ((++_sp & 255u) == 0u) { if (xb_ld(&(bar)[XB_TMO])) break; if (_sp > XB_SPIN_CAP) { atomicAdd(&(bar)[XB_TMO], 1u); break; } } } } while (0)

struct XcdBarrier {
    unsigned* bar; unsigned x;
    volatile LAS unsigned* st;
};

__device__ __forceinline__ XcdBarrier xcd_barrier_post(unsigned* bar, volatile LAS unsigned* st) {
    XcdBarrier b; b.bar = bar; b.x = xb_xcc_id(); b.st = st;
    if (threadIdx.x == 0) (void)xb_add(&bar[XB_XCNT(b.x)], 1u);
    return b;
}
__device__ __forceinline__ void xcd_barrier_complete(unsigned* bar, unsigned x, unsigned& nloc, unsigned& nx) {
    const unsigned G = gridDim.x * gridDim.y * gridDim.z;
    unsigned sum, cnt, mine, sp = 0u;
    for (;;) {
        sum = 0u; cnt = 0u; mine = 0u;
#pragma unroll
        for (unsigned j = 0; j < 16; ++j) { const unsigned c = xb_ld(&bar[XB_XCNT(j)]); sum += c; cnt += (c > 0u) ? 1u : 0u; mine = (j == x) ? c : mine; }
        if (sum == G) break;
        __builtin_amdgcn_s_sleep(1);
        if ((++sp & 255u) == 0u) { if (xb_ld(&bar[XB_TMO])) break; if (sp > XB_SPIN_CAP) { atomicAdd(&bar[XB_TMO], 1u); break; } }
    }
    nloc = mine > 0u ? mine : 1u; nx = cnt > 0u ? cnt : 1u;
}

__device__ __forceinline__ void xcd_barrier(const XcdBarrier& b) {
    asm volatile("s_waitcnt vmcnt(0)" ::: "memory");
    __syncthreads();
    if (threadIdx.x == 0) {
        unsigned* bar = b.bar;
        __builtin_amdgcn_s_waitcnt(0);
        unsigned nloc = b.st[0], nx = b.st[1];
        if (nloc == 0u) { xcd_barrier_complete(bar, b.x, nloc, nx); b.st[0] = nloc; b.st[1] = nx; }
        const unsigned old = xb_add(&bar[XB_XSUB(b.x)], 1u);
        const unsigned gen = old / nloc;
        if (old + 1u == (gen + 1u) * nloc) {
            __builtin_amdgcn_fence(__ATOMIC_RELEASE, "agent");
            asm volatile("s_waitcnt vmcnt(0)" ::: "memory");
            const unsigned og = xb_add(&bar[XB_TOP], 1u);
            const unsigned tg = og / nx;
            if (og + 1u == (tg + 1u) * nx) xb_add(&bar[XB_TOPGEN], 1u);
            else XB_SPIN(xb_ld(&bar[XB_TOPGEN]) == tg, bar);
            __builtin_amdgcn_fence(__ATOMIC_ACQUIRE, "agent");
            xb_add(&bar[XB_XGEN(b.x)], 1u);
            asm volatile("s_waitcnt vmcnt(0)" ::: "memory");
        } else {
            XB_SPIN(xb_ld(&bar[XB_XGEN(b.x)]) == gen, bar);
            __builtin_amdgcn_fence(__ATOMIC_ACQUIRE, "agent");
            asm volatile("s_waitcnt vmcnt(0)" ::: "memory");
        }
    }
    __syncthreads();
}
struct Frame {
    LAS unsigned char* lds;
    volatile LAS unsigned* MISC;
    gu32* ctl;
    int tid, lane, wave, vcu, G;
    const float *xp, *xs, *state, *norm1, *w_in, *w_s, *b_s, *norm_v, *lbl, *norm_o, *w_out, *norm2, *w_up, *w_dn, *norm_f;
    float* out;
    bf16 *Wt_in, *Wt_out, *Wt_up, *Wt_dn, *XN, *XN2, *U, *V, *Q, *LF, *I, *Gt, *HID;
};
template <int CTRL> __device__ __forceinline__ float dpp_f(float v) { return __builtin_bit_cast(float, __builtin_amdgcn_update_dpp(0, __builtin_bit_cast(int, v), CTRL, 0xf, 0xf, true)); }
__device__ __forceinline__ float sum8_dpp(float v) { v += dpp_f<0xB1>(v); v += dpp_f<0x4E>(v); v += dpp_f<0x141>(v); return v; }
__device__ __forceinline__ float wave_sum(float v) {
    v = sum8_dpp(v); v += dpp_f<0x140>(v);
    const int b = __builtin_bit_cast(int, v);
    return (__builtin_bit_cast(float, __builtin_amdgcn_readlane(b, 0)) + __builtin_bit_cast(float, __builtin_amdgcn_readlane(b, 16))) + (__builtin_bit_cast(float, __builtin_amdgcn_readlane(b, 32)) + __builtin_bit_cast(float, __builtin_amdgcn_readlane(b, 48)));
}
typedef __bf16 bf16x2_t __attribute__((ext_vector_type(2)));
__device__ __forceinline__ unsigned pkbf(float lo, float hi) { f32x2 v = {lo, hi}; bf16x2_t b = __builtin_convertvector(v, bf16x2_t); return __builtin_bit_cast(unsigned, b); }
__device__ __forceinline__ void p0_transpose_item(const float* W, int K, int N, bf16* WT, LAS unsigned char* scr, int item, int lane) {
    const int nblk = N / 64, kb = item / nblk, nb = item % nblk, k0 = 64 * kb, n0 = 64 * nb, kq = lane >> 4, n4 = 4 * (lane & 15);
    const GAS f32x4* wp = (const GAS f32x4*)(W + (size_t)(k0 + 16 * kq) * N + n0 + n4);
    const size_t rs = (size_t)(N / 4);
    f32x4 v[16];
#pragma unroll
    for (int i = 0; i < 16; ++i) v[i] = __builtin_nontemporal_load(wp + i * rs);
#pragma unroll
    for (int e = 0; e < 4; ++e) { v4u a, b;
        a.x = pkbf(v[0][e], v[1][e]); a.y = pkbf(v[2][e], v[3][e]); a.z = pkbf(v[4][e], v[5][e]); a.w = pkbf(v[6][e], v[7][e]);
        b.x = pkbf(v[8][e], v[9][e]); b.y = pkbf(v[10][e], v[11][e]); b.z = pkbf(v[12][e], v[13][e]); b.w = pkbf(v[14][e], v[15][e]);
        *(LAS v4u*)(scr + (n4 + e) * 144 + 32 * kq) = a; *(LAS v4u*)(scr + (n4 + e) * 144 + 32 * kq + 16) = b; }
    LDS_WAIT(); asm volatile("" ::: "memory");
    GAS unsigned char* op = (GAS unsigned char*)(WT + (size_t)(n0 + (lane >> 3)) * K + k0 + 8 * (lane & 7));
    const size_t os = (size_t)K * 2 * 8;
#pragma unroll
    for (int j = 0; j < 8; ++j) { const v4u o = *(const LAS v4u*)(scr + (8 * j + (lane >> 3)) * 144 + 16 * (lane & 7)); *(GAS v4u*)(op + j * os) = o; }
    LDS_WAIT(); asm volatile("" ::: "memory");
}
__device__ __forceinline__ void row_load(f32x4 (&v)[16], const float* xrow, int lane) { const GAS f32x4* xr = (const GAS f32x4*)xrow + lane;
#pragma unroll
    for (int j = 0; j < 16; ++j) v[j] = xr[64 * j]; }
__device__ __forceinline__ void row_load_nt(f32x4 (&v)[16], const float* xrow, int lane) { const GAS f32x4* xr = (const GAS f32x4*)xrow + lane;
#pragma unroll
    for (int j = 0; j < 16; ++j) v[j] = __builtin_nontemporal_load(xr + 64 * j); }
__device__ __forceinline__ void row_add_parts(f32x4 (&v)[16], const float* prow, int lane) {
#pragma unroll
    for (int ks = 0; ks < 8; ++ks) { const GAS f32x4* pr = (const GAS f32x4*)(prow + (size_t)ks * MS * DM) + lane;
#pragma unroll
        for (int j = 0; j < 16; ++j) v[j] = v[j] + pr[64 * j]; } }
__device__ __forceinline__ void row_store(const f32x4 (&v)[16], float* xrow, int lane) { GAS f32x4* xr = (GAS f32x4*)xrow + lane;
#pragma unroll
    for (int j = 0; j < 16; ++j) xr[64 * j] = v[j]; }
__device__ __forceinline__ float row_rstd(const f32x4 (&v)[16]) { float s = 0.f;
#pragma unroll
    for (int j = 0; j < 16; ++j) s += (v[j].x * v[j].x + v[j].y * v[j].y) + (v[j].z * v[j].z + v[j].w * v[j].w);
    return 1.0f / sqrtf(wave_sum(s) * (1.f / DM) + RMS_EPS); }
__device__ __forceinline__ void row_norm_to_bf16(const f32x4 (&v)[16], float r, const float* g, bf16* orow, int lane) {
    const GAS f32x4* gr = (const GAS f32x4*)g + lane; GAS v2u* o8 = (GAS v2u*)orow + lane;
#pragma unroll
    for (int j = 0; j < 16; ++j) { const f32x4 gg = gr[64 * j]; v2u o; o.x = pk2(v[j].x * r * gg.x, v[j].y * r * gg.y); o.y = pk2(v[j].z * r * gg.z, v[j].w * r * gg.w); o8[64 * j] = o; } }
__device__ __forceinline__ void row_norm_to_f32(const f32x4 (&v)[16], float r, const float* g, float* orow, int lane) {
    const GAS f32x4* gr = (const GAS f32x4*)g + lane; GAS f32x4* xr = (GAS f32x4*)orow + lane;
#pragma unroll
    for (int j = 0; j < 16; ++j) { const f32x4 gg = gr[64 * j]; __builtin_nontemporal_store((f32x4){v[j].x * r * gg.x, v[j].y * r * gg.y, v[j].z * r * gg.z, v[j].w * r * gg.w}, xr + 64 * j); } }
__device__ __forceinline__ float sample_row_sum(Frame& F, const float* baserow, const float* partrow, f32x4 (&v)[2]) {
    const GAS f32x4* bp = (const GAS f32x4*)baserow + 2 * F.tid; f32x4 p[8][2];
    v[0] = bp[0]; v[1] = bp[1];
#pragma unroll
    for (int ks = 0; ks < 8; ++ks) { const GAS f32x4* pp = (const GAS f32x4*)(partrow + (size_t)ks * MS * DM) + 2 * F.tid; p[ks][0] = __builtin_nontemporal_load(pp); p[ks][1] = __builtin_nontemporal_load(pp + 1); }
#pragma unroll
    for (int ks = 0; ks < 8; ++ks) { v[0] = v[0] + p[ks][0]; v[1] = v[1] + p[ks][1]; }
    float s = (v[0].x * v[0].x + v[0].y * v[0].y) + (v[0].z * v[0].z + v[0].w * v[0].w) + (v[1].x * v[1].x + v[1].y * v[1].y) + (v[1].z * v[1].z + v[1].w * v[1].w);
    s = wave_sum(s);
    LAS float* red = (LAS float*)(F.lds + RING_OFF);
    __syncthreads();
    if (F.lane == 0) red[F.wave] = s;
    __syncthreads();
    return ((red[0] + red[1]) + (red[2] + red[3])) + ((red[4] + red[5]) + (red[6] + red[7]));
}
__device__ __forceinline__ void p0_prologue(Frame& F) {
    LAS unsigned char* scr = F.lds + RING_OFF + F.wave * 16384;
    const int gw = F.vcu * NWAVES + F.wave, NGW = F.G * NWAVES;
    constexpr int I_IN = (DM / 64) * (NIN / 64);
    for (int it = gw; it < I_IN; it += NGW) p0_transpose_item(F.w_in, DM, NIN, F.Wt_in, scr, it, F.lane);
    for (int m = gw; m < MT; m += NGW) { f32x4 v[16]; row_load_nt(v, m < MP ? F.xp + (size_t)m * DM : F.xs + (size_t)(m - MP) * DM, F.lane); row_norm_to_bf16(v, row_rstd(v), F.norm1, F.XN + (size_t)m * DM, F.lane); }
}
constexpr int CV_OUT = (DM / 64) * (DM / 64), CV_UP = (DM / 64) * (DFF / 64), CV_DN = (DFF / 64) * (DM / 64), CV_ALL = CV_OUT + CV_UP + CV_DN;
constexpr int CV_TAIL1 = 12288;
constexpr int CV_TAIL2_LO = CV_OUT + CV_UP, CV_TAIL2_HI = CV_OUT + CV_UP + 9216;
template <int NW = NWAVES> __device__ __forceinline__ void convert_items(Frame& F, int lo, int hi, int rank, int n_wgs) {
    if (rank < 0 || lo >= hi) return;
    LAS unsigned char* scr = F.lds + RING_OFF + F.wave * 16384;
    __syncthreads();
    if (F.wave < NW) for (int it = lo + rank * NW + F.wave; it < hi; it += n_wgs * NW) {
        int r = it;
        if (r < CV_OUT) { p0_transpose_item(F.w_out, DM, DM, F.Wt_out, scr, r, F.lane); continue; } r -= CV_OUT;
        if (r < CV_UP) { p0_transpose_item(F.w_up, DM, DFF, F.Wt_up, scr, r, F.lane); continue; } r -= CV_UP;
        p0_transpose_item(F.w_dn, DFF, DM, F.Wt_dn, scr, r, F.lane);
    }
    __syncthreads();
}
typedef short bf16x8_t __attribute__((ext_vector_type(8)));
struct GUnit { int row0, h, L, sidx; };
__device__ __forceinline__ GUnit gmlp_unit(int u) { GUnit q; if (u < 1024) { const int b = u >> 8, n = (u >> 3) & 31; q.h = u & 7; q.row0 = b * 4096 + n * 128; q.L = 128; q.sidx = -1; } else { const int s = (u - 1024) >> 3; q.h = u & 7; q.row0 = MP + s * 16; q.L = 16; q.sidx = s; } return q; }
struct GRaw { v2u v[2][8]; v2u gu[8][2]; float bias[8]; f32x4 gain; };
__device__ __forceinline__ void gmlp_load(const Frame& F, GRaw& R, const GUnit& q) {
    const int lane = F.lane, wave = F.wave, fr = lane & 15, fq = lane >> 4, ntg = q.L >> 3, nit = (q.L == 16) ? 1 : 8;
#pragma unroll
    for (int g2 = 0; g2 < 2; ++g2) { const int tg = wave + 8 * g2;
        if (tg < ntg) { const GAS v2u* vp = (const GAS v2u*)(F.V + (size_t)(q.row0 + 8 * tg) * 2048 + q.h * 256 + 4 * lane);
#pragma unroll
            for (int r = 0; r < 8; ++r) R.v[g2][r] = __builtin_nontemporal_load(vp + r * 512); }
        else {
#pragma unroll
            for (int r = 0; r < 8; ++r) R.v[g2][r] = (v2u){0u, 0u}; } }
    const GAS v2u* up = (const GAS v2u*)(F.U + (size_t)(q.row0 + fr) * 2048 + q.h * 256 + 32 * wave + 4 * fq);
    const GAS float* bp = (const GAS float*)(F.b_s + q.h * 128 + fr);
#pragma unroll
    for (int it = 0; it < 8; ++it) { if (it < nit) { R.gu[it][0] = __builtin_nontemporal_load(up + it * 16 * 512); R.gu[it][1] = __builtin_nontemporal_load(up + it * 16 * 512 + 4); R.bias[it] = bp[16 * it]; } else { R.gu[it][0] = (v2u){0u, 0u}; R.gu[it][1] = R.gu[it][0]; R.bias[it] = 0.f; } }
    R.gain = *(const GAS f32x4*)(F.norm_v + q.h * 256 + 4 * lane);
}
__device__ __forceinline__ void gmlp_mfma(Frame& F) {
    constexpr int WSTR = 272, VSTR = 272;
    LAS unsigned char* WB = F.lds + RING_OFF;
    LAS unsigned char* VT = F.lds + RING_OFF + 128 * WSTR;
    const int tid = F.tid, lane = F.lane, wave = F.wave, fr = lane & 15, fq = lane >> 4;
    bf16* Y = F.XN;
    int last_h = -1;
    const int gu0 = (F.G > NHEAVY) ? ((int)blockIdx.x < NHEAVY ? 1280 : (int)blockIdx.x - NHEAVY) : (int)blockIdx.x, gstep = (F.G > NHEAVY) ? F.G - NHEAVY : F.G;
    GRaw cur;
    if (gu0 < 1280) gmlp_load(F, cur, gmlp_unit(gu0));
    for (int u = gu0; u < 1280; u += gstep) {
        const GUnit q = gmlp_unit(u); const int row0 = q.row0, h = q.h, L = q.L, sidx = q.sidx;
        const int ntg = L >> 3, nit = (L == 16) ? 1 : 8;
        GRaw nxt;
        if (u + gstep < 1280) gmlp_load(F, nxt, gmlp_unit(u + gstep));
        else nxt = cur;
        LBAR();
        if (h != last_h) {
            const int i = tid >> 2, j0 = (tid & 3) * 32;
            const GAS f32x4* wp = (const GAS f32x4*)(F.w_s + ((size_t)h * 128 + i) * 128 + j0);
            const bool keep = !(i < 64 && j0 >= 64);
#pragma unroll
            for (int c = 0; c < 4; ++c) { const f32x4 a = wp[2 * c], b = wp[2 * c + 1]; v4u o;
                o.x = keep ? pkbf(a.x, a.y) : 0u; o.y = keep ? pkbf(a.z, a.w) : 0u; o.z = keep ? pkbf(b.x, b.y) : 0u; o.w = keep ? pkbf(b.z, b.w) : 0u;
                *(LAS v4u*)(WB + i * WSTR + (j0 + 8 * c) * 2) = o; }
            last_h = h;
        }
#pragma unroll
        for (int g2 = 0; g2 < 2; ++g2) { const int tg = wave + 8 * g2;
            if (tg < ntg) {
                float x[8][4], ss[8];
#pragma unroll
                for (int r = 0; r < 8; ++r) { const v2u raw = cur.v[g2][r]; x[r][0] = bf2f(raw.x & 0xffffu); x[r][1] = bf2f(raw.x >> 16); x[r][2] = bf2f(raw.y & 0xffffu); x[r][3] = bf2f(raw.y >> 16);
                    ss[r] = (x[r][0] * x[r][0] + x[r][1] * x[r][1]) + (x[r][2] * x[r][2] + x[r][3] * x[r][3]); }
#pragma unroll
                for (int r = 0; r < 8; ++r) ss[r] = wave_sum(ss[r]);
#pragma unroll
                for (int r = 0; r < 8; ++r) { const float rs = 1.0f / sqrtf(ss[r] * (1.f / 256.f) + RMS_EPS);
                    x[r][0] *= rs * cur.gain.x; x[r][1] *= rs * cur.gain.y; x[r][2] *= rs * cur.gain.z; x[r][3] *= rs * cur.gain.w; }
                if (sidx >= 0) { GAS f32x4* op = (GAS f32x4*)(F.out + OUT_VS + (size_t)(sidx * 16 + 8 * tg) * 2048 + h * 256 + 4 * lane);
#pragma unroll
                    for (int r = 0; r < 8; ++r) op[r * 512] = (f32x4){x[r][0], x[r][1], x[r][2], x[r][3]}; }
#pragma unroll
                for (int e = 0; e < 4; ++e) { v4u o; o.x = pkbf(x[0][e], x[1][e]); o.y = pkbf(x[2][e], x[3][e]); o.z = pkbf(x[4][e], x[5][e]); o.w = pkbf(x[6][e], x[7][e]);
                    *(LAS v4u*)(VT + (4 * lane + e) * VSTR + 16 * tg) = o; }
            } else if (L == 16 && tg < 4) {
#pragma unroll
                for (int e = 0; e < 4; ++e) *(LAS v4u*)(VT + (4 * lane + e) * VSTR + 16 * tg) = (v4u){0u, 0u, 0u, 0u};
            }
        }
        LBAR();
        bf16x8_t a[2][4];
#pragma unroll
        for (int dt = 0; dt < 2; ++dt)
#pragma unroll
            for (int ks = 0; ks < 4; ++ks) a[dt][ks] = *(const LAS bf16x8_t*)(VT + (32 * wave + 16 * dt + fr) * VSTR + (32 * ks + 8 * fq) * 2);
        GAS v2u* yp = (GAS v2u*)(Y + (size_t)(row0 + fr) * DM + h * 256 + 32 * wave + 4 * fq);
#pragma unroll
        for (int it = 0; it < 8; ++it) {
            if (it < nit) {
                const int nks = (L == 16) ? 1 : (it < 4 ? 2 : 4);
                bf16x8_t b[4];
#pragma unroll
                for (int ks = 0; ks < 4; ++ks) b[ks] = *(const LAS bf16x8_t*)(WB + (16 * it + fr) * WSTR + (32 * ks + 8 * fq) * 2);
                f32x4 acc0 = (f32x4){0.f, 0.f, 0.f, 0.f}, acc1 = (f32x4){0.f, 0.f, 0.f, 0.f};
#pragma unroll
                for (int ks = 0; ks < 4; ++ks) {
                    if (ks < nks) { acc0 = __builtin_amdgcn_mfma_f32_16x16x32_bf16(a[0][ks], b[ks], acc0, 0, 0, 0); acc1 = __builtin_amdgcn_mfma_f32_16x16x32_bf16(a[1][ks], b[ks], acc1, 0, 0, 0); }
                }
                const float bias = cur.bias[it];
#pragma unroll
                for (int dt = 0; dt < 2; ++dt) { const f32x4 acc = dt ? acc1 : acc0; const v2u g = cur.gu[it][dt]; v2u o;
                    o.x = pkbf((acc.x + bias) * bf2f(g.x & 0xffffu), (acc.y + bias) * bf2f(g.x >> 16)); o.y = pkbf((acc.z + bias) * bf2f(g.y & 0xffffu), (acc.w + bias) * bf2f(g.y >> 16));
                    yp[it * 16 * (DM / 4) + 4 * dt] = o; }
            }
        }
        cur = nxt;
    }
    __syncthreads();
}
struct HRaw { unsigned q[8], f[8], i[8]; };
__device__ __forceinline__ void hgrn_load_raw(const Frame& F, HRaw& R, int row, int h, int valid) {
    const int t0 = 8 * F.wave;
    if (t0 < valid) {
#pragma unroll
        for (int r = 0; r < 8; ++r) { const size_t rb = (size_t)(row + t0 + r) * 2048 + h * 128 + 2 * F.lane;
            R.q[r] = __builtin_nontemporal_load((const GAS unsigned*)(F.Q + rb)); R.f[r] = __builtin_nontemporal_load((const GAS unsigned*)(F.LF + rb)); R.i[r] = __builtin_nontemporal_load((const GAS unsigned*)(F.I + rb)); }
    } else {
#pragma unroll
        for (int r = 0; r < 8; ++r) { R.q[r] = 0u; R.f[r] = 0x3C003C00u; R.i[r] = 0u; }
    }
}
__device__ __forceinline__ void hgrn_load_g(const Frame& F, v4u (&g)[2], int row, int h, int valid) {
    const int t = F.tid >> 3;
    if (8 * F.wave < valid) { const GAS v4u* gp = (const GAS v4u*)(F.Gt + (size_t)(row + t) * 2048 + h * 128 + 16 * (F.tid & 7)); g[0] = __builtin_nontemporal_load(gp); g[1] = __builtin_nontemporal_load(gp + 1); }
    else { g[0] = (v4u){0u, 0u, 0u, 0u}; g[1] = g[0]; }
}
__device__ __forceinline__ void hgrn_mfma(Frame& F) {
    constexpr int QSTR = 272, TSTR = 144, OSTR = 528;
    constexpr int L_QE = 0, L_QR = 17408, L_KR = 34816, L_KET = 52224, L_IT = 70656, L_P = 89088, L_TOT = 98304, L_PEND = 102912, L_NO = 103424, L_OS = 103936;
    static_assert(L_OS + 64 * OSTR <= LDSCTL_OFF, "HGRN2 LDS map");
    LAS unsigned char* const B0 = F.lds;
    const int lane = F.lane, wave = F.wave, fr = lane & 15, fq = lane >> 4, G = F.G, bx = (int)blockIdx.x;
    bf16* Y = F.XN;
    int u0, ustep; if (G > NHEAVY) { if (bx < NHEAVY) { u0 = bx; ustep = 1 << 20; } else { u0 = bx; ustep = G - NHEAVY; } } else { u0 = bx; ustep = G; }
    for (int u = u0; u < NHEAVY + 512; u += ustep) {
        int row0, nch, nfull, h, valid; const float* s0; float* sout;
        if (u < NHEAVY) { const int bh = u & 63, seg = u >> 6, b = bh >> 4; h = bh & 15; row0 = b * 4096; nch = seg ? 64 : HSPLIT; nfull = seg ? HSPLIT : 0; valid = 64; s0 = nullptr; sout = seg ? F.out + OUT_SP + (size_t)bh * 16384 : nullptr; }
        else { const int su = u - NHEAVY; h = su & 15; row0 = MP + (su >> 4) * 16; nch = 1; nfull = 0; valid = 16; s0 = F.state + (size_t)su * 16384; sout = F.out + OUT_SS + (size_t)su * 16384; }
        f32x4 S[8];
        if (s0) {
            const GAS float* sp = (const GAS float*)s0 + (4 * fq) * 128 + 16 * wave + fr;
#pragma unroll
            for (int dt = 0; dt < 8; ++dt)
#pragma unroll
                for (int e = 0; e < 4; ++e) S[dt][e] = sp[(16 * dt + e) * 128];
        } else {
#pragma unroll
            for (int dt = 0; dt < 8; ++dt) S[dt] = (f32x4){0.f, 0.f, 0.f, 0.f};
        }
        if (F.tid < 32) *(LAS f32x4*)(B0 + L_NO + 16 * F.tid) = *(const GAS f32x4*)(F.norm_o + h * 128 + 4 * F.tid);
        HRaw cur, nx1; v4u gcur[2], gnxt[2];
        hgrn_load_raw(F, cur, row0, h, valid); hgrn_load_g(F, gnxt, row0, h, valid);
        if (nch > 1) hgrn_load_raw(F, nx1, row0 + 64, h, valid); else nx1 = cur;
        gcur[0] = gnxt[0]; gcur[1] = gnxt[1];
        for (int n = -1; n < nch; ++n) {
            const bool has_cur = n >= 0, has_next = n + 1 < nch, full_cur = n >= nfull, full_next = has_next && n + 1 >= nfull;
            const int rowc = row0 + 64 * n;
            if (has_next) {
                float t0 = h2f(cur.f[0] & 0xffffu), t1 = h2f(cur.f[0] >> 16);
                if (wave == 4) *(LAS f32x2*)(B0 + L_TOT + (8 * 128 + 2 * lane) * 4) = (f32x2){t0, t1};
#pragma unroll
                for (int r = 1; r < 8; ++r) { t0 *= h2f(cur.f[r] & 0xffffu); t1 *= h2f(cur.f[r] >> 16); }
                *(LAS f32x2*)(B0 + L_TOT + (wave * 128 + 2 * lane) * 4) = (f32x2){t0, t1};
            }
            if (has_cur) {
                bf16x8_t bi[2];
#pragma unroll
                for (int ks = 0; ks < 2; ++ks) bi[ks] = *(const LAS bf16x8_t*)(B0 + L_IT + (16 * wave + fr) * TSTR + (32 * ks + 8 * fq) * 2);
                f32x4 o[4];
                if (full_cur) {
                    bf16x8_t sb[4];
#pragma unroll
                    for (int ks = 0; ks < 4; ++ks) { v4u p; p.x = pkbf(S[2 * ks][0], S[2 * ks][1]); p.y = pkbf(S[2 * ks][2], S[2 * ks][3]); p.z = pkbf(S[2 * ks + 1][0], S[2 * ks + 1][1]); p.w = pkbf(S[2 * ks + 1][2], S[2 * ks + 1][3]);
                        sb[ks] = __builtin_bit_cast(bf16x8_t, p); }
                    bf16x8_t pa[6]; v2u qlo[2][4], qhi[2][4];
                    pa[0] = *(const LAS bf16x8_t*)(B0 + L_P + (fr) * TSTR + (8 * fq) * 2); pa[1] = *(const LAS bf16x8_t*)(B0 + L_P + (16 + fr) * TSTR + (8 * fq) * 2);
                    pa[2] = *(const LAS bf16x8_t*)(B0 + L_P + (32 + fr) * TSTR + (8 * fq) * 2); pa[3] = *(const LAS bf16x8_t*)(B0 + L_P + (32 + fr) * TSTR + (32 + 8 * fq) * 2);
                    pa[4] = *(const LAS bf16x8_t*)(B0 + L_P + (48 + fr) * TSTR + (8 * fq) * 2); pa[5] = *(const LAS bf16x8_t*)(B0 + L_P + (48 + fr) * TSTR + (32 + 8 * fq) * 2);
                    SCHED_FENCE();
                    const f32x4 z4 = (f32x4){0.f, 0.f, 0.f, 0.f};
                    o[0] = __builtin_amdgcn_mfma_f32_16x16x32_bf16(pa[0], bi[0], z4, 0, 0, 0); o[1] = __builtin_amdgcn_mfma_f32_16x16x32_bf16(pa[1], bi[0], z4, 0, 0, 0);
                    o[2] = __builtin_amdgcn_mfma_f32_16x16x32_bf16(pa[2], bi[0], z4, 0, 0, 0); o[3] = __builtin_amdgcn_mfma_f32_16x16x32_bf16(pa[4], bi[0], z4, 0, 0, 0);
                    o[2] = __builtin_amdgcn_mfma_f32_16x16x32_bf16(pa[3], bi[1], o[2], 0, 0, 0); o[3] = __builtin_amdgcn_mfma_f32_16x16x32_bf16(pa[5], bi[1], o[3], 0, 0, 0);
                    SCHED_FENCE();
#pragma unroll
                    for (int hf = 0; hf < 2; ++hf) {
#pragma unroll
                        for (int tt = 0; tt < 2; ++tt)
#pragma unroll
                            for (int ks = 0; ks < 4; ++ks) { qlo[tt][ks] = *(const LAS v2u*)(B0 + L_QE + (32 * hf + 16 * tt + fr) * QSTR + (32 * ks + 4 * fq) * 2); qhi[tt][ks] = *(const LAS v2u*)(B0 + L_QE + (32 * hf + 16 * tt + fr) * QSTR + (32 * ks + 16 + 4 * fq) * 2); }
                        SCHED_FENCE();
#pragma unroll
                        for (int ks = 0; ks < 4; ++ks)
#pragma unroll
                            for (int tt = 0; tt < 2; ++tt) o[2 * hf + tt] = __builtin_amdgcn_mfma_f32_16x16x32_bf16(__builtin_bit_cast(bf16x8_t, (v4u){qlo[tt][ks].x, qlo[tt][ks].y, qhi[tt][ks].x, qhi[tt][ks].y}), sb[ks], o[2 * hf + tt], 0, 0, 0);
                        SCHED_FENCE();
                    }
                }
                {
                    f32x4 pe[8];
#pragma unroll
                    for (int dt = 0; dt < 8; ++dt) pe[dt] = *(const LAS f32x4*)(B0 + L_PEND + (16 * dt + 4 * fq) * 4);
#pragma unroll
                    for (int dt = 0; dt < 8; ++dt) S[dt] = S[dt] * pe[dt];
                }
                SCHED_FENCE();
#pragma unroll
                for (int hf = 0; hf < 2; ++hf) {
                    bf16x8_t ka[4][2];
#pragma unroll
                    for (int dt = 0; dt < 4; ++dt)
#pragma unroll
                        for (int ks = 0; ks < 2; ++ks) ka[dt][ks] = *(const LAS bf16x8_t*)(B0 + L_KET + (64 * hf + 16 * dt + fr) * TSTR + (32 * ks + 8 * fq) * 2);
                    SCHED_FENCE();
#pragma unroll
                    for (int ks = 0; ks < 2; ++ks)
#pragma unroll
                        for (int dt = 0; dt < 4; ++dt) S[4 * hf + dt] = __builtin_amdgcn_mfma_f32_16x16x32_bf16(ka[dt][ks], bi[ks], S[4 * hf + dt], 0, 0, 0);
                    SCHED_FENCE();
                }
                if (full_cur) {
#pragma unroll
                    for (int tt = 0; tt < 4; ++tt)
#pragma unroll
                        for (int e = 0; e < 4; ++e) *(LAS float*)(B0 + L_OS + (16 * tt + 4 * fq + e) * OSTR + (16 * wave + fr) * 4) = o[tt][e];
                }
            }
            LBAR();
            if (has_cur && full_cur) {
                const int t = F.tid >> 3, vg = F.tid & 7;
                f32x4 ov[4], no[4]; float ss = 0.f;
#pragma unroll
                for (int j = 0; j < 4; ++j) no[j] = *(const LAS f32x4*)(B0 + L_NO + 64 * vg + 16 * j);
#pragma unroll
                for (int j = 0; j < 4; ++j) { ov[j] = *(const LAS f32x4*)(B0 + L_OS + t * OSTR + 64 * vg + 16 * j); ss += (ov[j].x * ov[j].x + ov[j].y * ov[j].y) + (ov[j].z * ov[j].z + ov[j].w * ov[j].w); }
                ss = sum8_dpp(ss);
                const float rs = __builtin_amdgcn_rsqf(ss * (1.f / 128.f) + RMS_EPS);
                v4u y[2];
#pragma unroll
                for (int j = 0; j < 2; ++j) { const v4u g = gcur[j]; const f32x4 a = ov[2 * j] * no[2 * j] * rs, b = ov[2 * j + 1] * no[2 * j + 1] * rs;
                    y[j].x = pkbf(a.x * bf2f(g.x & 0xffffu), a.y * bf2f(g.x >> 16)); y[j].y = pkbf(a.z * bf2f(g.y & 0xffffu), a.w * bf2f(g.y >> 16));
                    y[j].z = pkbf(b.x * bf2f(g.z & 0xffffu), b.y * bf2f(g.z >> 16)); y[j].w = pkbf(b.z * bf2f(g.w & 0xffffu), b.w * bf2f(g.w >> 16)); }
                if (8 * wave < valid) { GAS v4u* yp = (GAS v4u*)(Y + (size_t)(rowc + t) * DM + 2048 + h * 128 + 16 * vg); yp[0] = y[0]; yp[1] = y[1]; }
            }
            if (has_next) {
                f32x2 tv[9];
#pragma unroll
                for (int w = 0; w < 9; ++w) tv[w] = *(const LAS f32x2*)(B0 + L_TOT + (w * 128 + 2 * lane) * 4);
                f32x2 off = (f32x2){1.f, 1.f}, pend = (f32x2){1.f, 1.f};
#pragma unroll
                for (int w = 0; w < 8; ++w) { if (w < wave) off = off * tv[w]; pend = pend * tv[w]; }
                const f32x2 p32 = tv[0] * tv[1] * tv[2] * tv[3] * tv[8];
                const f32x2 ip32 = (f32x2){__builtin_amdgcn_rcpf(p32.x), __builtin_amdgcn_rcpf(p32.y)};
                if (wave == 0) *(LAS f32x2*)(B0 + L_PEND + 8 * lane) = pend;
                float ke0[8], ke1[8]; float P0 = off.x, P1 = off.y;
#pragma unroll
                for (int r = 0; r < 8; ++r) {
                    P0 *= h2f(cur.f[r] & 0xffffu); P1 *= h2f(cur.f[r] >> 16);
                    const float r0 = __builtin_amdgcn_rcpf(P0), r1 = __builtin_amdgcn_rcpf(P1);
                    const float qe0 = bf2f(cur.q[r] & 0xffffu) * P0, qe1 = bf2f(cur.q[r] >> 16) * P1;
                    const float kk0 = (1.0f - h2f(cur.f[r] & 0xffffu)) * r0, kk1 = (1.0f - h2f(cur.f[r] >> 16)) * r1;
                    const int ro = (8 * wave + r) * QSTR + 4 * lane;
                    if (full_next) {
                        *(LAS unsigned*)(B0 + L_QE + ro) = pkbf(qe0, qe1);
                        *(LAS unsigned*)(B0 + L_QR + ro) = pkbf(qe0 * ip32.x, qe1 * ip32.y);
                        *(LAS unsigned*)(B0 + L_KR + ro) = pkbf(kk0 * p32.x, kk1 * p32.y); }
                    ke0[r] = kk0 * pend.x; ke1[r] = kk1 * pend.y;
                }
                v4u a, b, c, d;
                a.x = pkbf(ke0[0], ke0[1]); a.y = pkbf(ke0[2], ke0[3]); a.z = pkbf(ke0[4], ke0[5]); a.w = pkbf(ke0[6], ke0[7]);
                b.x = pkbf(ke1[0], ke1[1]); b.y = pkbf(ke1[2], ke1[3]); b.z = pkbf(ke1[4], ke1[5]); b.w = pkbf(ke1[6], ke1[7]);
                c.x = (cur.i[0] & 0xffffu) | (cur.i[1] << 16); c.y = (cur.i[2] & 0xffffu) | (cur.i[3] << 16); c.z = (cur.i[4] & 0xffffu) | (cur.i[5] << 16); c.w = (cur.i[6] & 0xffffu) | (cur.i[7] << 16);
                d.x = (cur.i[0] >> 16) | (cur.i[1] & 0xffff0000u); d.y = (cur.i[2] >> 16) | (cur.i[3] & 0xffff0000u); d.z = (cur.i[4] >> 16) | (cur.i[5] & 0xffff0000u); d.w = (cur.i[6] >> 16) | (cur.i[7] & 0xffff0000u);
                *(LAS v4u*)(B0 + L_KET + (2 * lane) * TSTR + 16 * wave) = a; *(LAS v4u*)(B0 + L_KET + (2 * lane + 1) * TSTR + 16 * wave) = b;
                *(LAS v4u*)(B0 + L_IT + (2 * lane) * TSTR + 16 * wave) = c; *(LAS v4u*)(B0 + L_IT + (2 * lane + 1) * TSTR + 16 * wave) = d;
            }
            LBAR();
            if (has_next) {
                cur = nx1;
                if (n + 3 < nch) hgrn_load_raw(F, nx1, rowc + 192, h, valid);
                gcur[0] = gnxt[0]; gcur[1] = gnxt[1];
                if (n + 2 < nch) hgrn_load_g(F, gnxt, rowc + 128, h, valid);
                if (full_next) {
                const int tt = wave >> 1, st0 = 2 * (wave & 1);
                bf16x8_t ka[2][4], qb[4];
#pragma unroll
                for (int ks = 0; ks < 4; ++ks) { qb[ks] = *(const LAS bf16x8_t*)(B0 + L_QR + (16 * tt + fr) * QSTR + (32 * ks + 8 * fq) * 2);
                    ka[0][ks] = *(const LAS bf16x8_t*)(B0 + L_KR + (16 * st0 + fr) * QSTR + (32 * ks + 8 * fq) * 2); ka[1][ks] = *(const LAS bf16x8_t*)(B0 + L_KR + (16 * st0 + 16 + fr) * QSTR + (32 * ks + 8 * fq) * 2); }
                SCHED_FENCE();
                f32x4 acc0 = (f32x4){0.f, 0.f, 0.f, 0.f}, acc1 = acc0;
#pragma unroll
                for (int ks = 0; ks < 4; ++ks) { acc0 = __builtin_amdgcn_mfma_f32_16x16x32_bf16(ka[0][ks], qb[ks], acc0, 0, 0, 0); acc1 = __builtin_amdgcn_mfma_f32_16x16x32_bf16(ka[1][ks], qb[ks], acc1, 0, 0, 0); }
#pragma unroll
                for (int e = 0; e < 4; ++e) { const int t = 16 * tt + fr; if (16 * st0 + 4 * fq + e > t) acc0[e] = 0.f; if (16 * st0 + 16 + 4 * fq + e > t) acc1[e] = 0.f; }
                *(LAS v2u*)(B0 + L_P + (16 * tt + fr) * TSTR + (16 * st0 + 4 * fq) * 2) = (v2u){pkbf(acc0.x, acc0.y), pkbf(acc0.z, acc0.w)};
                *(LAS v2u*)(B0 + L_P + (16 * tt + fr) * TSTR + (16 * st0 + 16 + 4 * fq) * 2) = (v2u){pkbf(acc1.x, acc1.y), pkbf(acc1.z, acc1.w)};
                LBAR();
                }
            }
        }
        if (sout) { GAS float* sp = (GAS float*)sout + (4 * fq) * 128 + 16 * wave + fr;
#pragma unroll
          for (int dt = 0; dt < 8; ++dt)
#pragma unroll
              for (int e = 0; e < 4; ++e) sp[(16 * dt + e) * 128] = S[dt][e]; }
        __syncthreads();
    }
}
struct Args { const float* in[15]; float* out; unsigned char* ws; int ph_lo, ph_hi, li, pad; };
__global__ void __launch_bounds__(NWAVES * 64, 2) fwd_kernel(Args args) {
    extern __shared__ __attribute__((aligned(16))) unsigned char lds[];
    Frame F;
    F.lds = (LAS unsigned char*)lds;
    F.MISC = (volatile LAS unsigned*)(F.lds + MISC_OFF);
    F.tid = threadIdx.x; F.lane = F.tid & 63; F.wave = __builtin_amdgcn_readfirstlane(F.tid >> 6);
    F.G = gridDim.x; { const int bx = blockIdx.x; F.vcu = (F.G % 8 == 0) ? (bx % 8) * (F.G / 8) + bx / 8 : bx; }
    unsigned char* ws = args.ws;
    F.ctl = (gu32*)(ws + WS_CTL);
    F.xp = args.in[0]; F.xs = args.in[1]; F.state = args.in[2]; F.norm1 = args.in[3]; F.w_in = args.in[4]; F.w_s = args.in[5]; F.b_s = args.in[6]; F.norm_v = args.in[7];
    F.lbl = args.in[8]; F.norm_o = args.in[9]; F.w_out = args.in[10]; F.norm2 = args.in[11]; F.w_up = args.in[12]; F.w_dn = args.in[13]; F.norm_f = args.in[14];
    F.out = args.out;
    F.Wt_in = (bf16*)(ws + WS_WIN); F.Wt_out = (bf16*)(ws + WS_WOUT); F.Wt_up = (bf16*)(ws + WS_WUP); F.Wt_dn = (bf16*)(ws + WS_WDN);
    F.XN = (bf16*)(ws + WS_XN); F.XN2 = (bf16*)(ws + WS_XN2);
    F.U = (bf16*)(ws + WS_P); F.V = (bf16*)(ws + WS_P + P_STRIDE); F.Q = (bf16*)(ws + WS_P + 2 * P_STRIDE); F.LF = (bf16*)(ws + WS_P + 3 * P_STRIDE);
    F.I = (bf16*)(ws + WS_P + 4 * P_STRIDE); F.Gt = (bf16*)(ws + WS_P + 5 * P_STRIDE); F.HID = (bf16*)(ws + WS_HID);
    for (int u = F.tid; u < (LDS_BYTES - LDSCTL_OFF) / 4; u += NWAVES * 64) ((LAS unsigned*)(F.lds + LDSCTL_OFF))[u] = 0u;
    __syncthreads();
    bool fused_final;
    { const GAS f32x4* g2p = (const GAS f32x4*)args.in[11] + 2 * F.tid; const f32x4 a = g2p[0], b = g2p[1];
      const float mn = fminf(fminf(fminf(fabsf(a.x), fabsf(a.y)), fminf(fabsf(a.z), fabsf(a.w))), fminf(fminf(fabsf(b.x), fabsf(b.y)), fminf(fabsf(b.z), fabsf(b.w))));
      if (!(mn > 0.015625f)) F.MISC[16] = 1u;
      __syncthreads();
      fused_final = (F.MISC[16] == 0u) && (F.G == 256); }
    XcdBarrier bar; bar.bar = (unsigned*)(F.ctl + CW_BAR); bar.x = 0; bar.st = nullptr;
    if (N_LAUNCHES != NPHASES) bar = xcd_barrier_post((unsigned*)(F.ctl + CW_BAR), F.MISC + 8);
#define GRID_BAR() do { if (N_LAUNCHES == NPHASES) { if (F.tid == 0) __hip_atomic_store(F.ctl + 0, 0xBADBA0u, RLX_AGENT); } else { xcd_barrier(bar); } } while (0)
    const int lo = args.ph_lo, hi = args.ph_hi;
#define IN(k) (lo <= (k) && (k) < hi)
#define BOTH(k) (IN(k) && IN((k) + 1))

    if (IN(0)) { p0_prologue(F); if (BOTH(0)) GRID_BAR(); }
    if (IN(1)) {
        pg8::Gemm g{F.XN, F.Wt_in, MT, NIN, DM, DM}; pg8::StaticOrder S; S.init(MT, NIN, F.G, (int)blockIdx.x);
        pg8::EpiProj E{F.U, F.lbl};
        pg8::gemm_phase<pg8::EpiProj, pg8::StaticOrder, true, true>(F.lds + RING_OFF, g, S, E);
        if (F.G == 256) convert_items(F, 0, CV_TAIL1, (int)blockIdx.x - (MT / 256 * (NIN / 256) - 12 * 256), 256 - (MT / 256 * (NIN / 256) - 12 * 256));
        if (BOTH(1)) GRID_BAR();
    }
    if (IN(2)) { gmlp_mfma(F); hgrn_mfma(F);
        { const int nl = (F.G > NHEAVY) ? F.G - NHEAVY : F.G, lid = (F.G > NHEAVY) ? (int)blockIdx.x - NHEAVY : (int)blockIdx.x; const bool tails = (F.G == 256);
          convert_items<2>(F, tails ? CV_TAIL1 : 0, tails ? CV_TAIL2_LO : CV_ALL, lid, nl); if (tails) convert_items<2>(F, CV_TAIL2_HI, CV_ALL, lid, nl); }
        if (BOTH(2)) GRID_BAR(); }
    if (IN(3)) { if (BOTH(3)) GRID_BAR(); }
    if (IN(4)) {
        { pg8::Gemm g{F.XN, F.Wt_out, MP, DM, DM, DM}; pg8::StaticOrder S; S.init(MP, DM, F.G, (int)blockIdx.x);
          pg8::EpiResNorm E{F.xp, F.out + OUT_Y, F.XN2, F.norm2, (float*)(ws + WS_CTL + CTL_SSQ), !fused_final};
          pg8::gemm_phase<pg8::EpiResNorm, pg8::StaticOrder, true, true>(F.lds + RING_OFF, g, S, E); }
        { pg8::Gemm g{F.XN, F.Wt_out, MT, DM, DM / 8, DM}; pg8::SplitOrder S; S.init(MP / 256, MS / 256, DM, 8, DM / 8, F.G, (int)blockIdx.x);
          pg8::EpiPart E{(float*)(ws + WS_PART1), DM / 8};
          pg8::gemm_phase<pg8::EpiPart, pg8::SplitOrder, true, true>(F.lds + RING_OFF, g, S, E); }
        if (BOTH(4)) GRID_BAR();
    }
    if (IN(5)) {
        float* ssq = (float*)(ws + WS_CTL + CTL_SSQ);
        for (int m = MP + (int)blockIdx.x; m < MT; m += F.G) {
            f32x4 v[2]; const float s = sample_row_sum(F, F.xs + (size_t)(m - MP) * DM, (const float*)(ws + WS_PART1) + (size_t)(m - MP) * DM, v);
            GAS f32x4* xo = (GAS f32x4*)(F.out + OUT_Y + (size_t)m * DM) + 2 * F.tid; xo[0] = v[0]; xo[1] = v[1];
            if (F.tid == 0) ssq[m] = s;
            const GAS f32x4* gp = (const GAS f32x4*)F.norm2 + 2 * F.tid; const f32x4 g0 = gp[0], g1 = gp[1];
            v4u o; o.x = pk2(v[0].x * g0.x, v[0].y * g0.y); o.y = pk2(v[0].z * g0.z, v[0].w * g0.w); o.z = pk2(v[1].x * g1.x, v[1].y * g1.y); o.w = pk2(v[1].z * g1.z, v[1].w * g1.w);
            *((GAS v4u*)(F.XN2 + (size_t)m * DM) + F.tid) = o; }
        if (BOTH(5)) GRID_BAR();
    }
    if (IN(6)) {
        pg8::Gemm g{F.XN2, F.Wt_up, MT, DFF, DM, DM}; pg8::StaticOrder S; S.init(MT, DFF, F.G, (int)blockIdx.x);
        pg8::EpiRelu2 E{F.HID, DFF, (const float*)(ws + WS_CTL + CTL_SSQ)};
        pg8::gemm_phase<pg8::EpiRelu2, pg8::StaticOrder, true, true>(F.lds + RING_OFF, g, S, E);
        if (F.G == 256) convert_items(F, CV_TAIL2_LO, CV_TAIL2_HI, (int)blockIdx.x - (MT / 256 * (DFF / 256) - 16 * 256), 256 - (MT / 256 * (DFF / 256) - 16 * 256));
        if (BOTH(6)) GRID_BAR();
    }
    if (IN(7)) {
        { pg8::Gemm g{F.HID, F.Wt_dn, MP, DM, DFF, DFF}; pg8::PairOrder S; S.init(MP, DM, F.G, (int)blockIdx.x);
          if (fused_final) { pg8::EpiResFinal E{F.out + OUT_Y, F.norm_f, (float*)(ws + WS_CTL + CTL_SSQ2), (unsigned*)(ws + WS_CTL + CTL_PANEL), F.XN2, F.norm2};
              pg8::gemm_phase<pg8::EpiResFinal, pg8::PairOrder, true, true>(F.lds + RING_OFF, g, S, E); }
          else { pg8::EpiRes E{F.out + OUT_Y, F.out + OUT_Y + (size_t)MP * DM, F.out + OUT_Y};
              pg8::gemm_phase<pg8::EpiRes, pg8::PairOrder, true, true>(F.lds + RING_OFF, g, S, E); } }
        { pg8::Gemm g{F.HID, F.Wt_dn, MT, DM, DFF / 8, DFF}; pg8::SplitOrder S; S.init(MP / 256, MS / 256, DM, 8, DFF / 8, F.G, (int)blockIdx.x);
          pg8::EpiPart E{(float*)(ws + WS_PART2), DFF / 8};
          pg8::gemm_phase<pg8::EpiPart, pg8::SplitOrder, true, true>(F.lds + RING_OFF, g, S, E); }
        if (BOTH(7)) GRID_BAR();
    }
    if (IN(8)) {
        const int gw = F.vcu * NWAVES + F.wave, NGW = F.G * NWAVES;
        for (int m = MP + (int)blockIdx.x; m < MT; m += F.G) {
            f32x4 v[2]; float* xrow = F.out + OUT_Y + (size_t)m * DM;
            const float s = sample_row_sum(F, xrow, (const float*)(ws + WS_PART2) + (size_t)(m - MP) * DM, v), r = 1.0f / sqrtf(s * (1.f / DM) + RMS_EPS);
            const GAS f32x4* gp = (const GAS f32x4*)F.norm_f + 2 * F.tid; const f32x4 g0 = gp[0], g1 = gp[1];
            GAS f32x4* xo = (GAS f32x4*)xrow + 2 * F.tid; xo[0] = v[0] * g0 * r; xo[1] = v[1] * g1 * r; }
        if (!fused_final) for (int m = gw; m < MP; m += NGW) { f32x4 v[16]; float* xrow = F.out + OUT_Y + (size_t)m * DM; row_load_nt(v, xrow, F.lane);
            row_norm_to_f32(v, row_rstd(v), F.norm_f, xrow, F.lane); }
    }
#undef IN
#undef BOTH
}

extern "C" void kernel_launch(void* const* d_in, const int* in_sizes, int n_in, void* d_out, int out_size, void* d_ws, size_t ws_size, hipStream_t stream) {
    static int grid = 0;
    if (grid == 0) {
        if (n_in != 15 || in_sizes[0] != MP * DM || (size_t)out_size != OUT_END || ws_size < WS_END) { fprintf(stderr, "kernel_launch: unexpected shapes (n_in %d, in0 %d, out %d, ws %zu); nothing launched\n", n_in, n_in > 0 ? in_sizes[0] : -1, out_size, ws_size); grid = -1; return; }
        int dev = 0, cus = 0, per_cu = 0;
        if (hipGetDevice(&dev) != hipSuccess || hipDeviceGetAttribute(&cus, hipDeviceAttributeMultiprocessorCount, dev) != hipSuccess) { grid = -1; return; }
        if (hipFuncSetAttribute((const void*)fwd_kernel, hipFuncAttributeMaxDynamicSharedMemorySize, LDS_BYTES) != hipSuccess) { fprintf(stderr, "kernel_launch: hipFuncSetAttribute failed\n"); grid = -1; return; }
        if (hipOccupancyMaxActiveBlocksPerMultiprocessor(&per_cu, (const void*)fwd_kernel, NWAVES * 64, LDS_BYTES) != hipSuccess || per_cu < 1) fprintf(stderr, "kernel_launch: occupancy query reports %d\n", per_cu);
        (void)hipGetLastError();
        grid = cus;
    }
    if (grid < 0) return;
    if (hipMemsetAsync((char*)d_ws + WS_CTL, 0, CTL_ZERO_BYTES, stream) != hipSuccess) return;
    Args a{};
    for (int i = 0; i < 15; ++i) a.in[i] = (const float*)d_in[i];
    a.out = (float*)d_out; a.ws = (unsigned char*)d_ws;
    for (int li = 0; li < N_LAUNCHES; ++li) {
        a.ph_lo = (N_LAUNCHES == NPHASES) ? li : 0; a.ph_hi = (N_LAUNCHES == NPHASES) ? li + 1 : NPHASES; a.li = li; a.pad = 0;
        hipLaunchKernelGGL(fwd_kernel, dim3(grid), dim3(NWAVES * 64), LDS_BYTES, stream, a);
        if (hipPeekAtLastError() != hipSuccess) break;
    }
}
```
